# Optimizing an MI355X kernel written in HIP

```python
import math
import jax, jax.numpy as jnp
from jax import lax
import numpy as np

D_MODEL = 2048
BATCH = 2
SEQ = 4096
DEPTH = 2

GRID_W = 64
CTX_LEN = 256
EPS = 1e-6
NEG = -1e30

HEAD_DIM = 128
W_A = D_MODEL // 4
W_B = D_MODEL // 2
W_C = D_MODEL // 4
MIX_W = W_A + W_B + W_C

CHUNK = 128
A_GROUPS = W_A // HEAD_DIM

B_HEADS = W_B // HEAD_DIM
Q_LORA = D_MODEL // 4
KV_LORA = 512
NOPE_DIM = 128
ROPE_DIM = 64
V_DIM = 128
MLA_SCALE = (NOPE_DIM + ROPE_DIM) ** -0.5
ROPE_THETA = 10000.0

C_HEADS = W_C // HEAD_DIM
MAX_KH = 8
KW = 16
C_SCALE = HEAD_DIM ** -0.5

Q_BLOCK = 128
SPLIT_WIDTHS = (W_A, W_A, W_A, Q_LORA, KV_LORA, ROPE_DIM, W_B, W_C, W_C, W_C, W_C)
IN_W = 3 * W_A + Q_LORA + KV_LORA + ROPE_DIM + W_B + 4 * W_C

kernel_name = "hybrid_gmlp_mla_natten_prefix_block"


def rmsnorm(x, g):
    xf = x.astype(jnp.float32)
    y = xf * lax.rsqrt(jnp.mean(xf * xf, axis=-1, keepdims=True) + EPS)
    return (y * g.astype(jnp.float32)).astype(x.dtype)


def split_in(z):
    offs, acc = [], 0
    for w in SPLIT_WIDTHS[:-1]:
        acc += w
        offs.append(acc)
    return jnp.split(z, offs, axis=-1)


def axial_angles(n_tokens):
    t = jnp.arange(n_tokens)
    row = (t // GRID_W).astype(jnp.float32)
    col = (t % GRID_W).astype(jnp.float32)
    n_freq = ROPE_DIM // 4
    inv = ROPE_THETA ** (-jnp.arange(n_freq, dtype=jnp.float32) / n_freq)
    return row[:, None] * inv, col[:, None] * inv


def _rotate(x, ang):
    m = x.shape[-1] // 2
    x1, x2 = x[..., :m], x[..., m:]
    cos = jnp.cos(ang).astype(x.dtype)
    sin = jnp.sin(ang).astype(x.dtype)
    return jnp.concatenate([x1 * cos - x2 * sin, x2 * cos + x1 * sin], axis=-1)


def axial_rope(x, ang_row, ang_col):
    half = ROPE_DIM // 2
    return jnp.concatenate([_rotate(x[..., :half], ang_row), _rotate(x[..., half:], ang_col)], axis=-1)


def chunk_gmlp(u, v, sgu_g, w_s, b_s):
    B, N, _ = u.shape
    u = jax.nn.gelu(u)
    v = rmsnorm(jax.nn.gelu(v), sgu_g).reshape(B, N // CHUNK, CHUNK, A_GROUPS, HEAD_DIM)
    s = jnp.einsum('gpq,bnqgc->bnpgc', w_s, v) + b_s.T[None, None, :, :, None]
    return u * s.reshape(B, N, W_A)


def mla_q(cq, qa_g, w_uq):
    B, N, _ = cq.shape
    q = (rmsnorm(cq, qa_g) @ w_uq).reshape(B, N, B_HEADS, NOPE_DIM + ROPE_DIM)
    return q[..., :NOPE_DIM], q[..., NOPE_DIM:]


def mla_kv(ckv, kva_g, w_ukv):
    B, N, _ = ckv.shape
    kv = (rmsnorm(ckv, kva_g) @ w_ukv).reshape(B, N, B_HEADS, NOPE_DIM + V_DIM)
    return kv[..., :NOPE_DIM], kv[..., NOPE_DIM:]


def mla_latent_attention(qn, qr, kn, kr, v, kn_c, kr_c, v_c):
    B, S, H, _ = qn.shape
    n_blocks = S // Q_BLOCK

    def block(i):
        qbn = lax.dynamic_slice_in_dim(qn, i * Q_BLOCK, Q_BLOCK, axis=1)
        qbr = lax.dynamic_slice_in_dim(qr, i * Q_BLOCK, Q_BLOCK, axis=1)
        s_lat = jnp.einsum('bqhd,bkhd->bhqk', qbn, kn) + jnp.einsum('bqhr,bkr->bhqk', qbr, kr)
        s_ctx = jnp.einsum('bqhd,bkhd->bhqk', qbn, kn_c) + jnp.einsum('bqhr,bkr->bhqk', qbr, kr_c)
        s = jnp.concatenate([s_lat, s_ctx], axis=-1).astype(jnp.float32) * MLA_SCALE
        p = jax.nn.softmax(s, axis=-1).astype(v.dtype)
        return (jnp.einsum('bhqk,bkhd->bqhd', p[..., :S], v)
                + jnp.einsum('bhqk,bkhd->bqhd', p[..., S:], v_c))

    out = lax.map(block, jnp.arange(n_blocks))
    return out.transpose(1, 0, 2, 3, 4).reshape(B, S, H * V_DIM)


def mla_context_attention(qn, qr, kn, kr, v):
    B, L, H, _ = qn.shape
    s = jnp.einsum('bqhd,bkhd->bhqk', qn, kn) + jnp.einsum('bqhr,bkr->bhqk', qr, kr)
    p = jax.nn.softmax(s.astype(jnp.float32) * MLA_SCALE, axis=-1).astype(v.dtype)
    return jnp.einsum('bhqk,bkhd->bqhd', p, v).reshape(B, L, H * V_DIM)


def dense_attention(q, k, v, scale):
    B, L, H, D = q.shape
    s = jnp.einsum('bqhd,bkhd->bhqk', q, k).astype(jnp.float32) * scale
    p = jax.nn.softmax(s, axis=-1).astype(v.dtype)
    return jnp.einsum('bhqk,bkhd->bqhd', p, v).reshape(B, L, H * D)


def natten_latent(q, k, v, k_c, v_c, rpb):
    B, S, H, D = q.shape
    rows = S // GRID_W
    kh = min(MAX_KH, rows)
    r = jnp.arange(rows)
    col = jnp.arange(GRID_W)
    r0 = jnp.clip(r - kh // 2, 0, rows - kh)
    row_idx = r0[:, None] + jnp.arange(kh)[None, :]
    c0 = jnp.clip(col - KW // 2, 0, GRID_W - KW)
    col_ok = (col[None, :] >= c0[:, None]) & (col[None, :] < c0[:, None] + KW)
    dr = row_idx - r[:, None] + (MAX_KH - 1)
    dc = jnp.clip(col[None, :] - col[:, None], -(KW - 1), KW - 1) + (KW - 1)
    bias = rpb[:, dr[:, None, :, None], dc[None, :, None, :]].astype(jnp.float32)
    bias = jnp.where(col_ok[None, None, :, None, :], bias, NEG)
    bias = bias.reshape(H, rows, GRID_W, kh * GRID_W).transpose(1, 0, 2, 3)

    qg = q.reshape(B, rows, GRID_W, H, D)
    kg = k.reshape(B, rows, GRID_W, H, D)
    vg = v.reshape(B, rows, GRID_W, H, D)
    n_keys = kh * GRID_W
    ks = kg[:, row_idx].reshape(B, rows, n_keys, H, D)
    vs = vg[:, row_idx].reshape(B, rows, n_keys, H, D)
    s_nb = jnp.einsum('brqhd,brkhd->brhqk', qg, ks).astype(jnp.float32) * C_SCALE + bias[None]
    s_cx = jnp.einsum('brqhd,blhd->brhql', qg, k_c).astype(jnp.float32) * C_SCALE
    p = jax.nn.softmax(jnp.concatenate([s_nb, s_cx], axis=-1), axis=-1).astype(v.dtype)
    o = (jnp.einsum('brhqk,brkhd->brqhd', p[..., :n_keys], vs)
         + jnp.einsum('brhql,blhd->brqhd', p[..., n_keys:], v_c))
    return o.reshape(B, S, H * D)


def hybrid_layer(x, xc, mod, mod_c, norm_g, w_in, qa_g, kva_g, w_uq, w_ukv,
                 sgu_g, w_s, b_s, rpb, w_out, ang_r, ang_c, ctx_out):
    B, S, _ = x.shape
    L = xc.shape[1]
    shift, scale, gate = jnp.split(mod, 3, axis=-1)
    shift_c, scale_c, gate_c = jnp.split(mod_c, 3, axis=-1)
    h = rmsnorm(x, norm_g) * (1.0 + scale[:, None, :]) + shift[:, None, :]
    hc = rmsnorm(xc, norm_g) * (1.0 + scale_c) + shift_c

    u, v_a, g_a, cq, ckv, kr, g_b, q_c, k_c, v_c, g_c = split_in(h @ w_in)
    (u_x, v_ax, g_ax, cq_x, ckv_x, kr_x, g_bx,
     q_cx, k_cx, v_cx, g_cx) = split_in(hc @ w_in)

    a_out = chunk_gmlp(u, v_a, sgu_g, w_s, b_s)

    qn, qr = mla_q(cq, qa_g, w_uq)
    qr = axial_rope(qr, ang_r[:, None, :], ang_c[:, None, :])
    kn, v_b = mla_kv(ckv, kva_g, w_ukv)
    kr = axial_rope(kr, ang_r, ang_c)
    kn_x, v_bx = mla_kv(ckv_x, kva_g, w_ukv)
    b_out = mla_latent_attention(qn, qr, kn, kr, v_b, kn_x, kr_x, v_bx)

    hd = lambda t, n: t.reshape(B, n, C_HEADS, HEAD_DIM)
    k_cx_h, v_cx_h = hd(k_cx, L), hd(v_cx, L)
    c_out = natten_latent(hd(q_c, S), hd(k_c, S), hd(v_c, S), k_cx_h, v_cx_h, rpb)

    y = jnp.concatenate([a_out * jax.nn.silu(g_a), b_out * jax.nn.silu(g_b),
                         c_out * jax.nn.silu(g_c)], axis=-1) @ w_out
    x_new = x + gate[:, None, :] * y

    if ctx_out:
        a_x = chunk_gmlp(u_x, v_ax, sgu_g, w_s, b_s)
        qn_x, qr_x = mla_q(cq_x, qa_g, w_uq)
        b_x = mla_context_attention(qn_x, qr_x, kn_x, kr_x, v_bx)
        c_x = dense_attention(hd(q_cx, L), k_cx_h, v_cx_h, C_SCALE)
        yc = jnp.concatenate([a_x * jax.nn.silu(g_ax), b_x * jax.nn.silu(g_bx),
                              c_x * jax.nn.silu(g_cx)], axis=-1) @ w_out
        xc = xc + gate_c * yc
    return x_new, xc


def setup_inputs(seed: int = 0) -> dict:
    key = jax.random.key(seed)
    ks = jax.random.split(key, 20)
    nrm = lambda k, shape, s: jax.random.normal(k, shape, jnp.float32) * s
    return {
        "x": nrm(ks[0], (BATCH, SEQ, D_MODEL), 1.0),
        "c": nrm(ks[1], (BATCH, D_MODEL), 1.0),
        "ctx": nrm(ks[2], (BATCH, CTX_LEN, D_MODEL), 1.0),
        "c_ctx": nrm(ks[3], (D_MODEL,), 1.0),
        "w_ada": nrm(ks[4], (DEPTH, D_MODEL, 3 * D_MODEL), 0.5 * D_MODEL ** -0.5),
        "b_ada": nrm(ks[5], (DEPTH, 3 * D_MODEL), 0.02),
        "norm_g": 1.0 + nrm(ks[6], (DEPTH, D_MODEL), 0.02),
        "w_in": nrm(ks[7], (DEPTH, D_MODEL, IN_W), D_MODEL ** -0.5),
        "qa_g": 1.0 + nrm(ks[8], (DEPTH, Q_LORA), 0.02),
        "kva_g": 1.0 + nrm(ks[9], (DEPTH, KV_LORA), 0.02),
        "w_uq": nrm(ks[10], (DEPTH, Q_LORA, B_HEADS * (NOPE_DIM + ROPE_DIM)), Q_LORA ** -0.5),
        "w_ukv": nrm(ks[11], (DEPTH, KV_LORA, B_HEADS * (NOPE_DIM + V_DIM)), KV_LORA ** -0.5),
        "sgu_g": 1.0 + nrm(ks[12], (DEPTH, W_A), 0.02),
        "w_s": nrm(ks[13], (DEPTH, A_GROUPS, CHUNK, CHUNK), CHUNK ** -0.5),
        "b_s": 1.0 + nrm(ks[14], (DEPTH, A_GROUPS, CHUNK), 0.02),
        "rpb": nrm(ks[15], (DEPTH, C_HEADS, 2 * MAX_KH - 1, 2 * KW - 1), 0.1),
        "w_out": nrm(ks[16], (DEPTH, MIX_W, D_MODEL), MIX_W ** -0.5),
        "final_g": 1.0 + nrm(ks[17], (D_MODEL,), 0.02),
    }


def reference(x, c, ctx, c_ctx, w_ada, b_ada, norm_g, w_in, qa_g, kva_g, w_uq, w_ukv,
              sgu_g, w_s, b_s, rpb, w_out, final_g):
    silu_c = jax.nn.silu(c)
    silu_cc = jax.nn.silu(c_ctx)
    ang_r, ang_c = axial_angles(x.shape[1])
    xc = ctx
    for l in range(DEPTH):
        mod = silu_c @ w_ada[l] + b_ada[l]
        mod_c = silu_cc @ w_ada[l] + b_ada[l]
        x, xc = hybrid_layer(x, xc, mod, mod_c, norm_g[l], w_in[l], qa_g[l], kva_g[l],
                             w_uq[l], w_ukv[l], sgu_g[l], w_s[l], b_s[l], rpb[l], w_out[l],
                             ang_r, ang_c, l < DEPTH - 1)
    return rmsnorm(x, final_g)
```

```cpp
#include <hip/hip_runtime.h>
#include <cstdio>
#include <cstdint>

#ifndef MK_ONE_LAUNCH
#define MK_ONE_LAUNCH 1
#endif

constexpr int D = 2048, NBATCH = 2, SEQ = 4096, CTX = 256, TROWS = SEQ + CTX  , MR = NBATCH * TROWS  ;
constexpr int DEPTH = 2, GRIDW = 64;
constexpr int INW = 5696;
constexpr int ZW = 5632;
constexpr int Z_U = 0, Z_VA = 512, Z_GA = 1024, Z_CQ = 1536, Z_CKV = 2048, Z_GB = 2560, Z_QC = 3584, Z_KC = 4096, Z_VC = 4608, Z_GC = 5120;
constexpr int NIN = 5696;
constexpr int QW = 1536, KVW = 2048, KRW = 64;
constexpr float EPS = 1e-6f;
constexpr float LOG2E = 1.4426950408889634f;
constexpr float MLA_QSCALE = 0.07216878364870322f * LOG2E;
constexpr float C_QSCALE = 0.08838834764831845f * LOG2E;

constexpr size_t MiB = 1u << 20;
constexpr size_t WS_CTL = 0, CTL_ZERO_BYTES = 1 * MiB;
constexpr size_t WS_MOD = 1 * MiB;
constexpr size_t WS_ROPE = WS_MOD + 256 * 1024;
constexpr size_t WS_ROWSQ = WS_ROPE + 64 * 1024;
constexpr size_t WS_XC = 2 * MiB;
constexpr size_t WS_KR = 6 * MiB;
constexpr size_t WS_WUQ = 8 * MiB;
constexpr size_t WS_WUKV = 11 * MiB;
constexpr size_t WS_WOUT = 15 * MiB;
constexpr size_t WS_WIN = 31 * MiB;
constexpr size_t WS_H = 77 * MiB;
constexpr size_t WS_Z = 111 * MiB;
constexpr size_t WS_Q = 205 * MiB;
constexpr size_t WS_KV = 231 * MiB;
constexpr size_t WS_MIX = 265 * MiB;
constexpr size_t WS_END = 299 * MiB;
constexpr int NIN_PAD = 5888;

#define GAS __attribute__((address_space(1)))
#define LAS __attribute__((address_space(3)))
typedef unsigned short bf16;
typedef unsigned v4u __attribute__((ext_vector_type(4)));
typedef unsigned v2u __attribute__((ext_vector_type(2)));
typedef float f32x4 __attribute__((ext_vector_type(4)));
typedef GAS unsigned gu32;
#define RLX_AGENT __ATOMIC_RELAXED, __HIP_MEMORY_SCOPE_AGENT
#define LDS_WAIT() asm volatile("s_waitcnt lgkmcnt(0)" ::: "memory")
#define VM_WAIT() asm volatile("s_waitcnt vmcnt(0)" ::: "memory")
constexpr int NWAVES = 8, NTHREADS = 512;

__device__ __forceinline__ unsigned f2bf(float f) { unsigned u = __builtin_bit_cast(unsigned, f); return (u + 0x7fffu + ((u >> 16) & 1u)) >> 16; }
__device__ __forceinline__ unsigned pk2(float lo, float hi) { return f2bf(lo) | (f2bf(hi) << 16); }
__device__ __forceinline__ float bf2f(unsigned short b) { return __builtin_bit_cast(float, (unsigned)b << 16); }
__device__ __forceinline__ float bflo(unsigned w) { return __builtin_bit_cast(float, w << 16); }
__device__ __forceinline__ float bfhi(unsigned w) { return __builtin_bit_cast(float, w & 0xffff0000u); }
__device__ __forceinline__ float fast_rcp(float x) { return __builtin_amdgcn_rcpf(x); }
__device__ __forceinline__ float silu_f(float x) { return x * fast_rcp(1.f + __builtin_amdgcn_exp2f(-LOG2E * x)); }
__device__ __forceinline__ float gelu_f(float x) { const float u = x + 0.044715f * x * x * x; return x * fast_rcp(1.f + __builtin_amdgcn_exp2f(-2.3022082f * u)); }
__device__ __forceinline__ float wave_sum(float v) {
#pragma unroll
    for (int o = 1; o < 64; o <<= 1) v += __shfl_xor(v, o);
    return v;
}
__device__ __forceinline__ float wave_max(float v) {
#pragma unroll
    for (int o = 1; o < 64; o <<= 1) v = fmaxf(v, __shfl_xor(v, o));
    return v;
}

#define XB_TMO      128
#define XB_XCNT(j)  (256  + 64 * (j))
#define XB_XSUB(j)  (1280 + 64 * (j))
#define XB_XGEN(j)  (2304 + 64 * (j))
#define XB_TOP      3328
#define XB_TOPGEN   3392
#define XCD_BAR_WORDS 3456
#define XB_SPIN_CAP (1u << 23)
__device__ __forceinline__ unsigned xb_ld(unsigned* p)              { return __hip_atomic_load(p, __ATOMIC_RELAXED, __HIP_MEMORY_SCOPE_AGENT); }
__device__ __forceinline__ unsigned xb_add(unsigned* p, unsigned v) { return __hip_atomic_fetch_add(p, v, __ATOMIC_RELAXED, __HIP_MEMORY_SCOPE_AGENT); }
__device__ __forceinline__ unsigned xb_xcc_id() { return (unsigned)__builtin_amdgcn_s_getreg((3 << 11) | 20) & 0xFu; }
#define XB_SPIN(cond, bar) do { unsigned _sp = 0; while (cond) { __builtin_amdgcn_s_sleep(1); \
    if ((++_sp & 255u) == 0u) { if (xb_ld(&(bar)[XB_TMO])) break; if (_sp > XB_SPIN_CAP) { atomicAdd(&(bar)[XB_TMO], 1u); break; } } } } while (0)
struct XcdBarrier { unsigned* bar; unsigned x; volatile LAS unsigned* st; };
__device__ __forceinline__ XcdBarrier xcd_barrier_post(unsigned* bar, volatile LAS unsigned* st) {
    XcdBarrier b; b.bar = bar; b.x = xb_xcc_id(); b.st = st;
    if (threadIdx.x == 0) (void)xb_add(&bar[XB_XCNT(b.x)], 1u);
    return b;
}
__device__ __forceinline__ void xcd_barrier_complete(unsigned* bar, unsigned x, unsigned& nloc, unsigned& nx) {
    const unsigned G = gridDim.x * gridDim.y * gridDim.z;
    unsigned sum, cnt, mine, sp = 0u;
    for (;;) {
        sum = 0u; cnt = 0u; mine = 0u;
#pragma unroll
        for (unsigned j = 0; j < 16; ++j) { const unsigned c = xb_ld(&bar[XB_XCNT(j)]); sum += c; cnt += (c > 0u) ? 1u : 0u; mine = (j == x) ? c : mine; }
        if (sum == G) break;
        __builtin_amdgcn_s_sleep(1);
        if ((++sp & 255u) == 0u) { if (xb_ld(&bar[XB_TMO])) break; if (sp > XB_SPIN_CAP) { atomicAdd(&bar[XB_TMO], 1u); break; } }
    }
    nloc = mine > 0u ? mine : 1u; nx = cnt > 0u ? cnt : 1u;
}
__device__ __forceinline__ void xcd_barrier(const XcdBarrier& b) {
    asm volatile("s_waitcnt vmcnt(0)" ::: "memory");
    __syncthreads();
    if (threadIdx.x == 0) {
        unsigned* bar = b.bar;
        __builtin_amdgcn_s_waitcnt(0);
        unsigned nloc = b.st[0], nx = b.st[1];
        if (nloc == 0u) { xcd_barrier_complete(bar, b.x, nloc, nx); b.st[0] = nloc; b.st[1] = nx; }
        const unsigned old = xb_add(&bar[XB_XSUB(b.x)], 1u);
        const unsigned gen = old / nloc;
        if (old + 1u == (gen + 1u) * nloc) {
            __builtin_amdgcn_fence(__ATOMIC_RELEASE, "agent");
            asm volatile("s_waitcnt vmcnt(0)" ::: "memory");
            const unsigned og = xb_add(&bar[XB_TOP], 1u);
            const unsigned tg = og / nx;
            if (og + 1u == (tg + 1u) * nx) xb_add(&bar[XB_TOPGEN], 1u);
            else XB_SPIN(xb_ld(&bar[XB_TOPGEN]) == tg, bar);
            __builtin_amdgcn_fence(__ATOMIC_ACQUIRE, "agent");
            xb_add(&bar[XB_XGEN(b.x)], 1u);
            asm volatile("s_waitcnt vmcnt(0)" ::: "memory");
        } else {
            XB_SPIN(xb_ld(&bar[XB_XGEN(b.x)]) == gen, bar);
            __builtin_amdgcn_fence(__ATOMIC_ACQUIRE, "agent");
            asm volatile("s_waitcnt vmcnt(0)" ::: "memory");
        }
    }
    __syncthreads();
}

constexpr int RING_BYTES = 147456;
constexpr int LDSCTL_OFF = RING_BYTES, MISC_OFF = LDSCTL_OFF + 320;
constexpr int LDS_BYTES = 151552;
constexpr int CW_BAR = 4096;

struct Args {
    const float* in[18]; float* out; unsigned char* ws; int ph_lo, ph_hi;
};
struct Frame {
    LAS unsigned char* lds; unsigned char* ws; int tid, lane, wave, vcu, G;
    const float *x, *c, *ctx, *c_ctx, *w_ada, *b_ada, *norm_g, *w_in, *qa_g, *kva_g, *w_uq, *w_ukv, *sgu_g, *w_s, *b_s, *rpb, *w_out, *final_g;
    float* out;
    float *mod, *rope, *rowsq, *xc;
    bf16 *kr, *wuq, *wukv, *wout, *win, *h, *z, *q, *kv, *mix;
};

__device__ __forceinline__ int row_b(int R) { return R >= TROWS ? 1 : 0; }

__device__ __forceinline__ void p0_transpose_item(const float* W, int K, int Nsrc, int nsrc0, bf16* WT, int nrow0, const float* gk, LAS float* scr, int k0, int lane) {
#pragma unroll 8
    for (int i = 0; i < 32; ++i) { const int kk = 2 * i + (lane >> 5); float v = W[(size_t)(k0 + kk) * Nsrc + nsrc0 + (lane & 31)]; if (gk) v *= gk[k0 + kk]; scr[kk * 33 + (lane & 31)] = v; }
    LDS_WAIT(); asm volatile("" ::: "memory");
    const int c = lane & 7;
#pragma unroll
    for (int j = 0; j < 4; ++j) { const int n = (lane >> 3) + 8 * j; const LAS float* s = scr + (8 * c) * 33 + n;
        v4u o; o.x = pk2(s[0 * 33], s[1 * 33]); o.y = pk2(s[2 * 33], s[3 * 33]); o.z = pk2(s[4 * 33], s[5 * 33]); o.w = pk2(s[6 * 33], s[7 * 33]);
        *(GAS v4u*)(WT + (size_t)(nrow0 + n) * K + k0 + 8 * c) = o; }
    LDS_WAIT(); asm volatile("" ::: "memory");
}
__device__ __forceinline__ void p0_prologue(Frame& F) {
    LAS float* scr = (LAS float*)(F.lds + F.wave * 16384);
    const int gw = F.vcu * NWAVES + F.wave, NGW = F.G * NWAVES;
    constexpr int I_IN = (NIN / 32) * (D / 64), I_OUT = (D / 32) * (D / 64), I_UQ = (QW / 32) * (512 / 64), I_UKV = (KVW / 32) * (512 / 64), I_L = I_IN + I_OUT + I_UQ + I_UKV;
    for (int it = gw; it < DEPTH * I_L; it += NGW) {
        const int l = it / I_L; int r = it % I_L;
        if (r < I_IN) { const int nb = r / (D / 64), kb = r % (D / 64); const int n0 = nb * 32; const int ns = n0 < 5632 ? (n0 < 2560 ? n0 : n0 + 64) : (2560 + (n0 - 5632));
            p0_transpose_item(F.w_in + (size_t)l * D * INW, D, INW, ns, F.win + (size_t)l * NIN_PAD * D, n0, nullptr, scr, kb * 64, F.lane); continue; } r -= I_IN;
        if (r < I_OUT) { const int nb = r / (D / 64), kb = r % (D / 64);
            p0_transpose_item(F.w_out + (size_t)l * D * D, D, D, nb * 32, F.wout + (size_t)l * D * D, nb * 32, nullptr, scr, kb * 64, F.lane); continue; } r -= I_OUT;
        if (r < I_UQ) { const int nb = r / 8, kb = r % 8;
            p0_transpose_item(F.w_uq + (size_t)l * 512 * QW, 512, QW, nb * 32, F.wuq + (size_t)l * QW * 512, nb * 32, F.qa_g + l * 512, scr, kb * 64, F.lane); continue; } r -= I_UQ;
        { const int nb = r / 8, kb = r % 8;
            p0_transpose_item(F.w_ukv + (size_t)l * 512 * KVW, 512, KVW, nb * 32, F.wukv + (size_t)l * KVW * 512, nb * 32, F.kva_g + l * 512, scr, kb * 64, F.lane); }
    }
    { const size_t per = (size_t)(NIN_PAD - NIN) * D / 8;
      for (size_t i = (size_t)blockIdx.x * NTHREADS + F.tid; i < DEPTH * per; i += (size_t)F.G * NTHREADS) { const size_t l = i / per, j = i % per;
          *(GAS v4u*)(F.win + l * NIN_PAD * D + (size_t)NIN * D + j * 8) = (v4u){0u, 0u, 0u, 0u}; } }
    for (int i = blockIdx.x * NTHREADS + F.tid; i < 1024; i += F.G * NTHREADS) { const int pos = i >> 4, fi = i & 15;
        const float inv = exp2f(-(float)fi * (13.287712379549449f / 16.f)); const float ang = (float)pos * inv;
        F.rope[i] = cosf(ang); F.rope[1024 + i] = sinf(ang); }
    __syncthreads();
    LAS float* sv = (LAS float*)F.lds;
    LAS float* red = (LAS float*)(F.lds + 32768);
    bool have_sv = false;
    for (int u = F.vcu; u < DEPTH * 192; u += F.G) {
        if (!have_sv) { for (int i = F.tid; i < 3 * D; i += NTHREADS) { const int j = i / D, k = i % D; const float cv = j < 2 ? F.c[j * D + k] : F.c_ctx[k]; sv[i] = silu_f(cv); } have_sv = true; __syncthreads(); }
        const int l = u / 192, n0 = (u % 192) * 32, col = F.lane & 31, kh = F.lane >> 5;
        const float* wp = F.w_ada + (size_t)l * D * 6144 + n0 + col;
        float a0 = 0.f, a1 = 0.f, a2 = 0.f;
#pragma unroll 8
        for (int i = 0; i < 128; ++i) { const int k = F.wave * 256 + 2 * i + kh; const float w = wp[(size_t)k * 6144]; a0 += sv[k] * w; a1 += sv[D + k] * w; a2 += sv[2 * D + k] * w; }
        a0 += __shfl_xor(a0, 32); a1 += __shfl_xor(a1, 32); a2 += __shfl_xor(a2, 32);
        if (F.lane < 32) { red[(F.wave * 3 + 0) * 32 + col] = a0; red[(F.wave * 3 + 1) * 32 + col] = a1; red[(F.wave * 3 + 2) * 32 + col] = a2; }
        __syncthreads();
        if (F.tid < 96) { const int j = F.tid / 32, cc = F.tid % 32; float s = 0.f;
#pragma unroll
            for (int w = 0; w < 8; ++w) s += red[(w * 3 + j) * 32 + cc];
            F.mod[(size_t)(l * 3 + j) * 6144 + n0 + cc] = s + F.b_ada[l * 6144 + n0 + cc]; }
        __syncthreads();
    }
}

__device__ __forceinline__ void sa_phase(Frame& F, int l) {
    const int gw = F.vcu * NWAVES + F.wave, NGW = F.G * NWAVES;
    const float* xl = (l == 0) ? F.x : F.out;
    const float* xcl = (l == 0) ? F.ctx : F.xc;
    for (int R = gw; R < MR; R += NGW) {
        const int b = row_b(R), t = R - b * TROWS; const bool isc = t >= SEQ;
        const float* src = isc ? xcl + ((size_t)b * CTX + (t - SEQ)) * D : xl + ((size_t)b * SEQ + t) * D;
        const float* md = F.mod + (size_t)(l * 3 + (isc ? 2 : b)) * 6144;
        const GAS f32x4* xr = (const GAS f32x4*)src + F.lane;
        f32x4 v[8]; float s = 0.f;
#pragma unroll
        for (int j = 0; j < 8; ++j) { v[j] = xr[64 * j]; s += (v[j].x * v[j].x + v[j].y * v[j].y) + (v[j].z * v[j].z + v[j].w * v[j].w); }
        const float rstd = 1.0f / sqrtf(wave_sum(s) * (1.f / D) + EPS);
        GAS v2u* o8 = (GAS v2u*)(F.h + (size_t)R * D) + F.lane;
#pragma unroll
        for (int j = 0; j < 8; ++j) { const int c0 = 4 * F.lane + 256 * j;
            const f32x4 g = *(const GAS f32x4*)(F.norm_g + l * D + c0), sh = *(const GAS f32x4*)(md + c0), sc = *(const GAS f32x4*)(md + D + c0);
            const f32x4 y = v[j] * rstd * g * (sc + 1.0f) + sh;
            o8[64 * j] = (v2u){pk2(y.x, y.y), pk2(y.z, y.w)}; }
    }
}
__device__ __forceinline__ void final_phase(Frame& F) {
    const int gw = F.vcu * NWAVES + F.wave, NGW = F.G * NWAVES;
    for (int R = gw; R < NBATCH * SEQ; R += NGW) {
        GAS f32x4* xr = (GAS f32x4*)(F.out + (size_t)R * D) + F.lane;
        f32x4 v[8]; float s = 0.f;
#pragma unroll
        for (int j = 0; j < 8; ++j) { v[j] = xr[64 * j]; s += (v[j].x * v[j].x + v[j].y * v[j].y) + (v[j].z * v[j].z + v[j].w * v[j].w); }
        const float rstd = 1.0f / sqrtf(wave_sum(s) * (1.f / D) + EPS);
#pragma unroll
        for (int j = 0; j < 8; ++j) { const f32x4 g = *(const GAS f32x4*)(F.final_g + 4 * F.lane + 256 * j); xr[64 * j] = v[j] * rstd * g; }
    }
}

template <class Epi>
__device__ __forceinline__ void naive_gemm(Frame& F, const bf16* A, int lda, const bf16* Bt, int M, int N, int K, const Epi& E) {
    LAS float* As = (LAS float*)F.lds;
    LAS float* Bs = (LAS float*)(F.lds + 32 * 132 * 4);
    const int tid = F.tid, ty = tid >> 4, tx = tid & 15;
    const int nM = M / 128, nN = N / 64;
    for (int u = F.vcu; u < nM * nN; u += F.G) {
        const int pm = u / nN, pn = u % nN, r0 = pm * 128, n0 = pn * 64;
        float acc[4][4];
#pragma unroll
        for (int i = 0; i < 4; ++i)
#pragma unroll
            for (int j = 0; j < 4; ++j) acc[i][j] = 0.f;
        for (int k0 = 0; k0 < K; k0 += 32) {
            { const int row = tid >> 2, kc = (tid & 3) * 8; const v4u w = *(const GAS v4u*)(A + (size_t)(r0 + row) * lda + k0 + kc);
              As[(kc + 0) * 132 + row] = bflo(w.x); As[(kc + 1) * 132 + row] = bfhi(w.x); As[(kc + 2) * 132 + row] = bflo(w.y); As[(kc + 3) * 132 + row] = bfhi(w.y);
              As[(kc + 4) * 132 + row] = bflo(w.z); As[(kc + 5) * 132 + row] = bfhi(w.z); As[(kc + 6) * 132 + row] = bflo(w.w); As[(kc + 7) * 132 + row] = bfhi(w.w); }
            { const int row = tid >> 3, kc = (tid & 7) * 4; const v2u w = *(const GAS v2u*)(Bt + (size_t)(n0 + row) * K + k0 + kc);
              Bs[(kc + 0) * 68 + row] = bflo(w.x); Bs[(kc + 1) * 68 + row] = bfhi(w.x); Bs[(kc + 2) * 68 + row] = bflo(w.y); Bs[(kc + 3) * 68 + row] = bfhi(w.y); }
            __syncthreads();
#pragma unroll 8
            for (int k = 0; k < 32; ++k) {
                const f32x4 a = *(const LAS f32x4*)(As + k * 132 + 4 * ty);
                float bv[4];
#pragma unroll
                for (int j = 0; j < 4; ++j) bv[j] = Bs[k * 68 + tx + 16 * j];
#pragma unroll
                for (int j = 0; j < 4; ++j) { acc[0][j] += a.x * bv[j]; acc[1][j] += a.y * bv[j]; acc[2][j] += a.z * bv[j]; acc[3][j] += a.w * bv[j]; }
            }
            __syncthreads();
        }
#pragma unroll
        for (int i = 0; i < 4; ++i) { const int R = r0 + 4 * ty + i; E.pair(F, R, n0 + tx, acc[i][0], acc[i][1]); E.pair(F, R, n0 + 32 + tx, acc[i][2], acc[i][3]); }
    }
}
__device__ __forceinline__ void st_bf(bf16* p, float v) { *(GAS bf16*)p = (bf16)f2bf(v); }
__device__ __forceinline__ void rope_pair(const float* rope, int pos, int i, float& x1, float& x2) {
    const float cs = rope[pos * 16 + i], sn = rope[1024 + pos * 16 + i]; const float a = x1 * cs - x2 * sn, b = x2 * cs + x1 * sn; x1 = a; x2 = b;
}
struct EpiWin {
    __device__ __forceinline__ float act(int n, float v) const {
        if (n < Z_GA) return gelu_f(v);
        if (n < Z_CQ) return silu_f(v);
        if (n < Z_GB) return v;
        if (n < Z_QC) return silu_f(v);
        if (n < Z_KC) return v * C_QSCALE;
        if (n < Z_GC) return v;
        return silu_f(v);
    }
    __device__ __forceinline__ void pair(Frame& F, int R, int n, float v0, float v1) const {
        if (n < ZW) { st_bf(F.z + (size_t)R * ZW + n, act(n, v0)); st_bf(F.z + (size_t)R * ZW + n + 16, act(n + 16, v1)); }
        else { const int d = n - ZW; const int b = row_b(R), t = R - b * TROWS;
            if (t < SEQ) { const int pos = d < 32 ? (t >> 6) : (t & 63); rope_pair(F.rope, pos, d & 15, v0, v1); }
            st_bf(F.kr + (size_t)R * KRW + d, v0); st_bf(F.kr + (size_t)R * KRW + d + 16, v1); }
    }
};
struct EpiKV {
    __device__ __forceinline__ void pair(Frame& F, int R, int n, float v0, float v1) const {
        const float rs = 1.0f / sqrtf(F.rowsq[2 * MR + R] * (1.f / 512.f) + EPS);
        st_bf(F.kv + (size_t)R * KVW + n, v0 * rs); st_bf(F.kv + (size_t)R * KVW + n + 16, v1 * rs);
    }
};
struct EpiQ {
    __device__ __forceinline__ void pair(Frame& F, int R, int n, float v0, float v1) const {
        const float rs = 1.0f / sqrtf(F.rowsq[1 * MR + R] * (1.f / 512.f) + EPS);
        v0 *= rs; v1 *= rs; const int d = n % 192; const int b = row_b(R), t = R - b * TROWS;
        if (d >= 128 && t < SEQ) { const int dd = d - 128; const int pos = dd < 32 ? (t >> 6) : (t & 63); rope_pair(F.rope, pos, dd & 15, v0, v1); }
        st_bf(F.q + (size_t)R * QW + n, v0 * MLA_QSCALE); st_bf(F.q + (size_t)R * QW + n + 16, v1 * MLA_QSCALE);
    }
};
struct EpiOut {
    int l;
    __device__ __forceinline__ void one(Frame& F, int R, int n, float v) const {
        const int b = row_b(R), t = R - b * TROWS;
        if (t < SEQ) { const size_t o = ((size_t)b * SEQ + t) * D + n; const float base = (l == 0) ? F.x[o] : F.out[o]; F.out[o] = base + F.mod[(size_t)(l * 3 + b) * 6144 + 2 * D + n] * v; }
        else if (l == 0) { const size_t o = ((size_t)b * CTX + (t - SEQ)) * D + n; F.xc[o] = F.ctx[o] + F.mod[(size_t)(l * 3 + 2) * 6144 + 2 * D + n] * v; }
    }
    __device__ __forceinline__ void pair(Frame& F, int R, int n, float v0, float v1) const { one(F, R, n, v0); one(F, R, n + 16, v1); }
};

__device__ __forceinline__ void rowsq_from_z(Frame& F) {
    const int gw = F.vcu * NWAVES + F.wave, NGW = F.G * NWAVES;
    for (int R = gw; R < MR; R += NGW) {
#pragma unroll
        for (int j = 0; j < 3; ++j) { const int c0 = j == 0 ? Z_VA : (j == 1 ? Z_CQ : Z_CKV);
            const v4u w = *(const GAS v4u*)(F.z + (size_t)R * ZW + c0 + 8 * F.lane);
            float s = bflo(w.x) * bflo(w.x) + bfhi(w.x) * bfhi(w.x) + bflo(w.y) * bflo(w.y) + bfhi(w.y) * bfhi(w.y) + bflo(w.z) * bflo(w.z) + bfhi(w.z) * bfhi(w.z) + bflo(w.w) * bflo(w.w) + bfhi(w.w) * bfhi(w.w);
            s = wave_sum(s); if (F.lane == 0) F.rowsq[j * MR + R] = s; }
    }
}

__device__ __forceinline__ void gmlp_naive(Frame& F, int l) {
    LAS float* Vs = (LAS float*)F.lds;
    LAS float* Ws = (LAS float*)(F.lds + 65536);
    const int nchunk = MR / 128;
    for (int u = F.vcu; u < nchunk * 4; u += F.G) {
        const int ch = u >> 2, g = u & 3; const int R0 = ch * 128; const int t0 = R0 % TROWS;
        if (l == DEPTH - 1 && t0 >= SEQ) continue;
        for (int i = F.tid; i < 128 * 128; i += NTHREADS) { const int q = i >> 7, c = i & 127;
            const float rs = 1.0f / sqrtf(F.rowsq[0 * MR + R0 + q] * (1.f / 512.f) + EPS);
            Vs[i] = bf2f(F.z[(size_t)(R0 + q) * ZW + Z_VA + g * 128 + c]) * rs;
            Ws[q * 129 + c] = F.w_s[((size_t)(l * 4 + g) * 128 + q) * 128 + c]; }
        __syncthreads();
        for (int i = F.tid; i < 128 * 128; i += NTHREADS) { const int p = i >> 7, c = i & 127; float s = 0.f;
            for (int q = 0; q < 128; ++q) s += Ws[p * 129 + q] * Vs[q * 128 + c];
            const int cc = g * 128 + c; const size_t zr = (size_t)(R0 + p) * ZW;
            const float sv = s * F.sgu_g[l * 512 + cc] + F.b_s[(l * 4 + g) * 128 + p];
            st_bf(F.mix + (size_t)(R0 + p) * D + cc, bf2f(F.z[zr + Z_U + cc]) * sv * bf2f(F.z[zr + Z_GA + cc])); }
        __syncthreads();
    }
}

constexpr int NA_SC = 4352, NA_WAVE_FLOATS = NA_SC + 192;
__device__ __forceinline__ void mla_naive(Frame& F, int l) {
    LAS float* sc = (LAS float*)F.lds + F.wave * NA_WAVE_FLOATS; LAS float* qs = sc + NA_SC;
    const int gw = F.vcu * NWAVES + F.wave, NGW = F.G * NWAVES;
    for (int it = gw; it < MR * 8; it += NGW) {
        const int R = it >> 3, hh = it & 7; const int b = row_b(R), t = R - b * TROWS; const bool isc = t >= SEQ;
        if (isc && l == DEPTH - 1) continue;
        const int kbase = b * TROWS + (isc ? SEQ : 0), nk = isc ? CTX : TROWS;
        for (int d = F.lane; d < 192; d += 64) qs[d] = bf2f(F.q[(size_t)R * QW + hh * 192 + d]);
        LDS_WAIT();
        float m = -3.0e38f;
        for (int j = F.lane; j < nk; j += 64) { const int Rk = kbase + j; float s = 0.f;
            const bf16* kn = F.kv + (size_t)Rk * KVW + hh * 256; const bf16* kr = F.kr + (size_t)Rk * KRW;
            for (int d = 0; d < 128; d += 8) { const v4u w = *(const GAS v4u*)(kn + d);
                s += qs[d] * bflo(w.x) + qs[d + 1] * bfhi(w.x) + qs[d + 2] * bflo(w.y) + qs[d + 3] * bfhi(w.y) + qs[d + 4] * bflo(w.z) + qs[d + 5] * bfhi(w.z) + qs[d + 6] * bflo(w.w) + qs[d + 7] * bfhi(w.w); }
            for (int d = 0; d < 64; d += 8) { const v4u w = *(const GAS v4u*)(kr + d);
                s += qs[128 + d] * bflo(w.x) + qs[129 + d] * bfhi(w.x) + qs[130 + d] * bflo(w.y) + qs[131 + d] * bfhi(w.y) + qs[132 + d] * bflo(w.z) + qs[133 + d] * bfhi(w.z) + qs[134 + d] * bflo(w.w) + qs[135 + d] * bfhi(w.w); }
            sc[j] = s; m = fmaxf(m, s); }
        m = wave_max(m); float sum = 0.f;
        for (int j = F.lane; j < nk; j += 64) { const float p = __builtin_amdgcn_exp2f(sc[j] - m); sc[j] = p; sum += p; }
        sum = wave_sum(sum); LDS_WAIT();
        float o0 = 0.f, o1 = 0.f;
        for (int j = 0; j < nk; ++j) { const float p = sc[j]; const unsigned w = *(const GAS unsigned*)(F.kv + (size_t)(kbase + j) * KVW + hh * 256 + 128 + 2 * F.lane); o0 += p * bflo(w); o1 += p * bfhi(w); }
        const float inv = 1.0f / sum; const unsigned gw2 = *(const GAS unsigned*)(F.z + (size_t)R * ZW + Z_GB + hh * 128 + 2 * F.lane);
        *(GAS unsigned*)(F.mix + (size_t)R * D + 512 + hh * 128 + 2 * F.lane) = pk2(o0 * inv * bflo(gw2), o1 * inv * bfhi(gw2));
        LDS_WAIT();
    }
}
__device__ __forceinline__ void natten_naive(Frame& F, int l) {
    LAS float* sc = (LAS float*)F.lds + F.wave * NA_WAVE_FLOATS; LAS float* qs = sc + NA_SC;
    const int gw = F.vcu * NWAVES + F.wave, NGW = F.G * NWAVES;
    for (int it = gw; it < MR * 4; it += NGW) {
        const int R = it >> 2, hh = it & 3; const int b = row_b(R), t = R - b * TROWS; const bool isc = t >= SEQ;
        if (isc && l == DEPTH - 1) continue;
        const int gr = t >> 6, gc = t & 63; const int r0 = min(max(gr - 4, 0), 56), c0 = min(max(gc - 8, 0), 48);
        const int nk = isc ? CTX : 128 + CTX;
        for (int d = F.lane; d < 128; d += 64) qs[d] = bf2f(F.z[(size_t)R * ZW + Z_QC + hh * 128 + d]);
        LDS_WAIT();
        float m = -3.0e38f;
        for (int j = F.lane; j < nk; j += 64) { int Rk; float bias = 0.f;
            if (!isc && j < 128) { const int kr_ = r0 + (j >> 4), kc = c0 + (j & 15); Rk = b * TROWS + kr_ * 64 + kc;
                bias = F.rpb[((size_t)(l * 4 + hh) * 15 + (kr_ - gr + 7)) * 31 + (kc - gc + 15)] * LOG2E; }
            else Rk = b * TROWS + SEQ + (isc ? j : j - 128);
            float s = 0.f; const bf16* kp = F.z + (size_t)Rk * ZW + Z_KC + hh * 128;
            for (int d = 0; d < 128; d += 8) { const v4u w = *(const GAS v4u*)(kp + d);
                s += qs[d] * bflo(w.x) + qs[d + 1] * bfhi(w.x) + qs[d + 2] * bflo(w.y) + qs[d + 3] * bfhi(w.y) + qs[d + 4] * bflo(w.z) + qs[d + 5] * bfhi(w.z) + qs[d + 6] * bflo(w.w) + qs[d + 7] * bfhi(w.w); }
            s += bias; sc[j] = s; m = fmaxf(m, s); }
        m = wave_max(m); float sum = 0.f;
        for (int j = F.lane; j < nk; j += 64) { const float p = __builtin_amdgcn_exp2f(sc[j] - m); sc[j] = p; sum += p; }
        sum = wave_sum(sum); LDS_WAIT();
        float o0 = 0.f, o1 = 0.f;
        for (int j = 0; j < nk; ++j) { int Rk;
            if (!isc && j < 128) Rk = b * TROWS + (r0 + (j >> 4)) * 64 + c0 + (j & 15); else Rk = b * TROWS + SEQ + (isc ? j : j - 128);
            const float p = sc[j]; const unsigned w = *(const GAS unsigned*)(F.z + (size_t)Rk * ZW + Z_VC + hh * 128 + 2 * F.lane); o0 += p * bflo(w); o1 += p * bfhi(w); }
        const float inv = 1.0f / sum; const unsigned gw2 = *(const GAS unsigned*)(F.z + (size_t)R * ZW + Z_GC + hh * 128 + 2 * F.lane);
        *(GAS unsigned*)(F.mix + (size_t)R * D + 1536 + hh * 128 + 2 * F.lane) = pk2(o0 * inv * bflo(gw2), o1 * inv * bfhi(gw2));
        LDS_WAIT();
    }
}

constexpr int NPHASES = 14;
__global__ void __launch_bounds__(NTHREADS, 2) mk_fwd(Args args) {
    extern __shared__ __attribute__((aligned(16))) unsigned char lds[];
    Frame F;
    F.lds = (LAS unsigned char*)lds; F.ws = args.ws;
    F.tid = threadIdx.x; F.lane = F.tid & 63; F.wave = __builtin_amdgcn_readfirstlane(F.tid >> 6);
    F.G = gridDim.x; { const int bx = blockIdx.x; F.vcu = (F.G % 8 == 0) ? (bx % 8) * (F.G / 8) + bx / 8 : bx; }
    F.x = args.in[0]; F.c = args.in[1]; F.ctx = args.in[2]; F.c_ctx = args.in[3]; F.w_ada = args.in[4]; F.b_ada = args.in[5]; F.norm_g = args.in[6]; F.w_in = args.in[7];
    F.qa_g = args.in[8]; F.kva_g = args.in[9]; F.w_uq = args.in[10]; F.w_ukv = args.in[11]; F.sgu_g = args.in[12]; F.w_s = args.in[13]; F.b_s = args.in[14]; F.rpb = args.in[15];
    F.w_out = args.in[16]; F.final_g = args.in[17]; F.out = args.out;
    unsigned char* ws = args.ws;
    F.mod = (float*)(ws + WS_MOD); F.rope = (float*)(ws + WS_ROPE); F.rowsq = (float*)(ws + WS_ROWSQ); F.xc = (float*)(ws + WS_XC);
    F.kr = (bf16*)(ws + WS_KR); F.wuq = (bf16*)(ws + WS_WUQ); F.wukv = (bf16*)(ws + WS_WUKV); F.wout = (bf16*)(ws + WS_WOUT); F.win = (bf16*)(ws + WS_WIN);
    F.h = (bf16*)(ws + WS_H); F.z = (bf16*)(ws + WS_Z); F.q = (bf16*)(ws + WS_Q); F.kv = (bf16*)(ws + WS_KV); F.mix = (bf16*)(ws + WS_MIX);
    volatile LAS unsigned* MISC = (volatile LAS unsigned*)(F.lds + MISC_OFF);
    for (int u = F.tid; u < (LDS_BYTES - LDSCTL_OFF) / 4; u += NTHREADS) ((LAS unsigned*)(F.lds + LDSCTL_OFF))[u] = 0u;
    __syncthreads();
    XcdBarrier bar; bar.bar = (unsigned*)(ws + WS_CTL) + CW_BAR; bar.x = 0; bar.st = nullptr;
    if (MK_ONE_LAUNCH) bar = xcd_barrier_post((unsigned*)(ws + WS_CTL) + CW_BAR, MISC + 8);
    const int lo = args.ph_lo, hi = args.ph_hi;
#define IN(k) (lo <= (k) && (k) < hi)
#define SEAM(k) do { if (IN(k) && IN((k) + 1)) xcd_barrier(bar); } while (0)
    if (IN(0)) { p0_prologue(F); } SEAM(0);
    for (int l = 0; l < DEPTH; ++l) {
        const int pb = 1 + 6 * l;
        if (IN(pb + 0)) { sa_phase(F, l); } SEAM(pb + 0);
        if (IN(pb + 1)) { __syncthreads(); naive_gemm(F, F.h, D, F.win + (size_t)l * NIN_PAD * D, MR, NIN, D, EpiWin{}); } SEAM(pb + 1);
        if (IN(pb + 2)) { rowsq_from_z(F); } SEAM(pb + 2);
        if (IN(pb + 3)) {
            __syncthreads(); naive_gemm(F, F.z + Z_CKV, ZW, F.wukv + (size_t)l * KVW * 512, MR, KVW, 512, EpiKV{});
            __syncthreads(); naive_gemm(F, F.z + Z_CQ, ZW, F.wuq + (size_t)l * QW * 512, MR, QW, 512, EpiQ{});
            __syncthreads(); gmlp_naive(F, l);
            __syncthreads(); natten_naive(F, l);
        } SEAM(pb + 3);
        if (IN(pb + 4)) { __syncthreads(); mla_naive(F, l); } SEAM(pb + 4);
        if (IN(pb + 5)) { __syncthreads(); naive_gemm(F, F.mix, D, F.wout + (size_t)l * D * D, MR, D, D, EpiOut{l}); } SEAM(pb + 5);
    }
    if (IN(13)) { final_phase(F); }
#undef IN
#undef SEAM
}

extern "C" void kernel_launch(void* const* d_in, const int* in_sizes, int n_in, void* d_out, int out_size, void* d_ws, size_t ws_size, hipStream_t stream) {
    static int grid = 0;
    if (grid == 0) {
        if (n_in != 18 || in_sizes[0] != NBATCH * SEQ * D || out_size != NBATCH * SEQ * D || ws_size < WS_END) {
            fprintf(stderr, "kernel_launch: unexpected shapes: n_in %d in0 %d out %d ws %zu (need %zu)\n", n_in, n_in > 0 ? in_sizes[0] : -1, out_size, ws_size, (size_t)WS_END); grid = -1; return; }
        int dev = 0, cus = 0;
        if (hipGetDevice(&dev) != hipSuccess || hipDeviceGetAttribute(&cus, hipDeviceAttributeMultiprocessorCount, dev) != hipSuccess) { grid = -1; return; }
        if (hipFuncSetAttribute((const void*)mk_fwd, hipFuncAttributeMaxDynamicSharedMemorySize, LDS_BYTES) != hipSuccess) { fprintf(stderr, "kernel_launch: hipFuncSetAttribute failed\n"); grid = -1; return; }
        int per_cu = 0;
        if (hipOccupancyMaxActiveBlocksPerMultiprocessor(&per_cu, (const void*)mk_fwd, NTHREADS, LDS_BYTES) != hipSuccess || per_cu < 1) fprintf(stderr, "kernel_launch: occupancy query says %d\n", per_cu);
        (void)hipGetLastError();
        grid = cus;
    }
    if (grid < 0) return;
    (void)hipMemsetAsync((char*)d_ws + WS_CTL, 0, CTL_ZERO_BYTES, stream);
    Args a{};
    for (int i = 0; i < 18; ++i) a.in[i] = (const float*)d_in[i];
    a.out = (float*)d_out; a.ws = (unsigned char*)d_ws;
#if MK_ONE_LAUNCH
    a.ph_lo = 0; a.ph_hi = NPHASES;
    hipLaunchKernelGGL(mk_fwd, dim3(grid), dim3(NTHREADS), LDS_BYTES, stream, a);
#else
    for (int p = 0; p < NPHASES; ++p) { a.ph_lo = p; a.ph_hi = p + 1; hipLaunchKernelGGL(mk_fwd, dim3(grid), dim3(NTHREADS), LDS_BYTES, stream, a); }
#endif
    const hipError_t le = hipPeekAtLastError();
    if (le != hipSuccess) fprintf(stderr, "kernel_launch: launch failed: %s\n", hipGetErrorName(le));
}
```

```cpp
#include <hip/hip_runtime.h>
#include <cstdio>
#include <cstdint>

#ifndef MK_ONE_LAUNCH
#define MK_ONE_LAUNCH 1
#endif
#ifndef FAST_MLA
#define FAST_MLA 1
#endif
#ifndef FAST_GEMM
#define FAST_GEMM 1
#endif

constexpr int D = 2048, NBATCH = 2, SEQ = 4096, CTX = 256, TROWS = SEQ + CTX  , MR = NBATCH * TROWS  ;
constexpr int DEPTH = 2, GRIDW = 64;
constexpr int INW = 5696;
constexpr int ZW = 5632;
constexpr int Z_U = 0, Z_VA = 512, Z_GA = 1024, Z_CQ = 1536, Z_CKV = 2048, Z_GB = 2560, Z_QC = 3584, Z_KC = 4096, Z_VC = 4608, Z_GC = 5120;
constexpr int NIN = 5696;
constexpr int QW = 1536, KVW = 2048, KRW = 64;
constexpr float EPS = 1e-6f;
constexpr float LOG2E = 1.4426950408889634f;
constexpr float MLA_QSCALE = 0.07216878364870322f * LOG2E;
constexpr float C_QSCALE = 0.08838834764831845f * LOG2E;

constexpr size_t MiB = 1u << 20;
constexpr size_t WS_CTL = 0, CTL_ZERO_BYTES = 1 * MiB;
constexpr size_t WS_MOD = 1 * MiB;
constexpr size_t WS_ROPE = WS_MOD + 256 * 1024;
constexpr size_t WS_ROWSQ = 7296 * 1024;
constexpr size_t WS_XC = 2 * MiB;
constexpr size_t WS_KR = 6 * MiB;
constexpr size_t WS_WUQ = 8 * MiB;
constexpr size_t WS_WUKV = 11 * MiB;
constexpr size_t WS_WOUT = 15 * MiB;
constexpr size_t WS_WIN = 31 * MiB;
constexpr size_t WS_H = 77 * MiB;
constexpr size_t WS_Z = 111 * MiB;
constexpr size_t WS_Q = 205 * MiB;
constexpr size_t WS_KV = 231 * MiB;
constexpr size_t WS_MIX = 265 * MiB;
constexpr size_t WS_END = 299 * MiB;
constexpr int NIN_PAD = 5888;

#define GAS __attribute__((address_space(1)))
#define LAS __attribute__((address_space(3)))
typedef unsigned short bf16;
typedef unsigned v4u __attribute__((ext_vector_type(4)));
typedef unsigned v2u __attribute__((ext_vector_type(2)));
typedef float f32x4 __attribute__((ext_vector_type(4)));
typedef GAS unsigned gu32;
#define RLX_AGENT __ATOMIC_RELAXED, __HIP_MEMORY_SCOPE_AGENT
#define LDS_WAIT() asm volatile("s_waitcnt lgkmcnt(0)" ::: "memory")
#define VM_WAIT() asm volatile("s_waitcnt vmcnt(0)" ::: "memory")
constexpr int NWAVES = 8, NTHREADS = 512;
__device__ __forceinline__ int fresh_tid() { int t = threadIdx.x; asm volatile("" : "+v"(t)); return t; }
#define PHASE_IDS(F) do { (F).tid = fresh_tid(); (F).lane = (F).tid & 63; (F).wave = __builtin_amdgcn_readfirstlane((F).tid >> 6); } while (0)

__device__ __forceinline__ unsigned f2bf(float f) { unsigned u = __builtin_bit_cast(unsigned, f); return (u + 0x7fffu + ((u >> 16) & 1u)) >> 16; }
__device__ __forceinline__ unsigned pk2(float lo, float hi) { return f2bf(lo) | (f2bf(hi) << 16); }
__device__ __forceinline__ float bf2f(unsigned short b) { return __builtin_bit_cast(float, (unsigned)b << 16); }
__device__ __forceinline__ float bflo(unsigned w) { return __builtin_bit_cast(float, w << 16); }
__device__ __forceinline__ float bfhi(unsigned w) { return __builtin_bit_cast(float, w & 0xffff0000u); }
__device__ __forceinline__ float fast_rcp(float x) { return __builtin_amdgcn_rcpf(x); }
__device__ __forceinline__ float silu_f(float x) { return x * fast_rcp(1.f + __builtin_amdgcn_exp2f(-LOG2E * x)); }
__device__ __forceinline__ float gelu_f(float x) { const float u = x + 0.044715f * x * x * x; return x * fast_rcp(1.f + __builtin_amdgcn_exp2f(-2.3022082f * u)); }
__device__ __forceinline__ float rstd512(const float* rsq, int j, int row) {
    float s = 0.f;
#pragma unroll
    for (int k = 0; k < 8; ++k) s += rsq[(size_t)(j * 8 + k) * MR + row];
    return 1.0f / sqrtf(s * (1.f / 512.f) + EPS);
}
template <int K> __device__ __forceinline__ float swz_xor(float v) { return __builtin_bit_cast(float, __builtin_amdgcn_ds_swizzle(__builtin_bit_cast(int, v), (K << 10) | 0x1F)); }
__device__ __forceinline__ float sum32(float v) { auto rr = __builtin_amdgcn_permlane32_swap(__float_as_uint(v), __float_as_uint(v), false, false); return __uint_as_float(rr[0]) + __uint_as_float(rr[1]); }
__device__ __forceinline__ float wave_sum(float v) {
    v += swz_xor<1>(v); v += swz_xor<2>(v); v += swz_xor<4>(v); v += swz_xor<8>(v); v += swz_xor<16>(v);
    { auto rr = __builtin_amdgcn_permlane32_swap(__float_as_uint(v), __float_as_uint(v), false, false); v = __uint_as_float(rr[0]) + __uint_as_float(rr[1]); }
    return v;
}
__device__ __forceinline__ float wave_max(float v) {
    v = fmaxf(v, swz_xor<1>(v)); v = fmaxf(v, swz_xor<2>(v)); v = fmaxf(v, swz_xor<4>(v)); v = fmaxf(v, swz_xor<8>(v)); v = fmaxf(v, swz_xor<16>(v));
    { auto rr = __builtin_amdgcn_permlane32_swap(__float_as_uint(v), __float_as_uint(v), false, false); v = fmaxf(__uint_as_float(rr[0]), __uint_as_float(rr[1])); }
    return v;
}

#define XB_TMO      128
#define XB_XCNT(j)  (256  + 64 * (j))
#define XB_XSUB(j)  (1280 + 64 * (j))
#define XB_XGEN(j)  (2304 + 64 * (j))
#define XB_TOP      3328
#define XB_TOPGEN   3392
#define XCD_BAR_WORDS 3456
#define XB_SPIN_CAP (1u << 23)
__device__ __forceinline__ unsigned xb_ld(unsigned* p)              { return __hip_atomic_load(p, __ATOMIC_RELAXED, __HIP_MEMORY_SCOPE_AGENT); }
__device__ __forceinline__ unsigned xb_add(unsigned* p, unsigned v) { return __hip_atomic_fetch_add(p, v, __ATOMIC_RELAXED, __HIP_MEMORY_SCOPE_AGENT); }
__device__ __forceinline__ unsigned xb_xcc_id() { return (unsigned)__builtin_amdgcn_s_getreg((3 << 11) | 20) & 0xFu; }
#define XB_SPIN(cond, bar) do { unsigned _sp = 0; while (cond) { __builtin_amdgcn_s_sleep(1); \
    if ((++_sp & 255u) == 0u) { if (xb_ld(&(bar)[XB_TMO])) break; if (_sp > XB_SPIN_CAP) { atomicAdd(&(bar)[XB_TMO], 1u); break; } } } } while (0)
struct XcdBarrier { unsigned* bar; unsigned x; volatile LAS unsigned* st; };
__device__ __forceinline__ XcdBarrier xcd_barrier_post(unsigned* bar, volatile LAS unsigned* st) {
    XcdBarrier b; b.bar = bar; b.x = xb_xcc_id(); b.st = st;
    if (threadIdx.x == 0) (void)xb_add(&bar[XB_XCNT(b.x)], 1u);
    return b;
}
__device__ __forceinline__ void xcd_barrier_complete(unsigned* bar, unsigned x, unsigned& nloc, unsigned& nx) {
    const unsigned G = gridDim.x * gridDim.y * gridDim.z;
    unsigned sum, cnt, mine, sp = 0u;
    for (;;) {
        sum = 0u; cnt = 0u; mine = 0u;
#pragma unroll
        for (unsigned j = 0; j < 16; ++j) { const unsigned c = xb_ld(&bar[XB_XCNT(j)]); sum += c; cnt += (c > 0u) ? 1u : 0u; mine = (j == x) ? c : mine; }
        if (sum == G) break;
        __builtin_amdgcn_s_sleep(1);
        if ((++sp & 255u) == 0u) { if (xb_ld(&bar[XB_TMO])) break; if (sp > XB_SPIN_CAP) { atomicAdd(&bar[XB_TMO], 1u); break; } }
    }
    nloc = mine > 0u ? mine : 1u; nx = cnt > 0u ? cnt : 1u;
}
__device__ __forceinline__ void xcd_barrier(const XcdBarrier& b) {
    asm volatile("s_waitcnt vmcnt(0)" ::: "memory");
    __syncthreads();
    if (threadIdx.x == 0) {
        unsigned* bar = b.bar; asm volatile("" : "+s"(bar));
        __builtin_amdgcn_s_waitcnt(0);
        unsigned nloc = b.st[0], nx = b.st[1];
        if (nloc == 0u) { xcd_barrier_complete(bar, b.x, nloc, nx); b.st[0] = nloc; b.st[1] = nx; }
        const unsigned old = xb_add(&bar[XB_XSUB(b.x)], 1u);
        const unsigned gen = old / nloc;
        if (old + 1u == (gen + 1u) * nloc) {
            __builtin_amdgcn_fence(__ATOMIC_RELEASE, "agent");
            asm volatile("s_waitcnt vmcnt(0)" ::: "memory");
            const unsigned og = xb_add(&bar[XB_TOP], 1u);
            const unsigned tg = og / nx;
            if (og + 1u == (tg + 1u) * nx) xb_add(&bar[XB_TOPGEN], 1u);
            else XB_SPIN(xb_ld(&bar[XB_TOPGEN]) == tg, bar);
            __builtin_amdgcn_fence(__ATOMIC_ACQUIRE, "agent");
            xb_add(&bar[XB_XGEN(b.x)], 1u);
            asm volatile("s_waitcnt vmcnt(0)" ::: "memory");
        } else {
            XB_SPIN(xb_ld(&bar[XB_XGEN(b.x)]) == gen, bar);
            __builtin_amdgcn_fence(__ATOMIC_ACQUIRE, "agent");
            asm volatile("s_waitcnt vmcnt(0)" ::: "memory");
        }
    }
    __syncthreads();
}

constexpr int RING_BYTES = 147456;
constexpr int LDSCTL_OFF = RING_BYTES, MISC_OFF = LDSCTL_OFF + 320;
constexpr int LDS_BYTES = 151552;
constexpr int CW_BAR = 4096;

struct Args {
    const float* in[18]; float* out; unsigned char* ws; int ph_lo, ph_hi;
};
struct Frame {
    LAS unsigned char* lds; unsigned char* ws; int tid, lane, wave, vcu, G;
    const float *x, *c, *ctx, *c_ctx, *w_ada, *b_ada, *norm_g, *w_in, *qa_g, *kva_g, *w_uq, *w_ukv, *sgu_g, *w_s, *b_s, *rpb, *w_out, *final_g;
    float* out;
    float *mod, *rope, *rowsq, *xc;
    bf16 *kr, *wuq, *wukv, *wout, *win, *h, *z, *q, *kv, *mix;
};

__device__ __forceinline__ int row_b(int R) { return R >= TROWS ? 1 : 0; }

__device__ __forceinline__ void p0_transpose_item(const float* W, int K, int Nsrc, int nsrc0, bf16* WT, int nrow0, const float* gk, LAS float* scr, int k0, int lane, bool ropeperm) {
#pragma unroll 8
    for (int i = 0; i < 32; ++i) { const int kk = 2 * i + (lane >> 5); float v = W[(size_t)(k0 + kk) * Nsrc + nsrc0 + (lane & 31)]; if (gk) v *= gk[k0 + kk]; scr[kk * 33 + (lane & 31)] = v; }
    LDS_WAIT(); asm volatile("" ::: "memory");
    const int c = lane & 7;
#pragma unroll
    for (int j = 0; j < 4; ++j) { const int n = (lane >> 3) + 8 * j; const LAS float* s = scr + (8 * c) * 33 + n;
        v4u o; o.x = pk2(s[0 * 33], s[1 * 33]); o.y = pk2(s[2 * 33], s[3 * 33]); o.z = pk2(s[4 * 33], s[5 * 33]); o.w = pk2(s[6 * 33], s[7 * 33]);
        const int nd = ropeperm ? (8 * ((n >> 2) & 3) + 4 * (n >> 4) + (n & 3)) : n;
        *(GAS v4u*)(WT + (size_t)(nrow0 + nd) * K + k0 + 8 * c) = o; }
    LDS_WAIT(); asm volatile("" ::: "memory");
}
__device__ __forceinline__ void p0_prologue(Frame& F) {
    PHASE_IDS(F);
    LAS float* scr = (LAS float*)(F.lds + F.wave * 16384);
    const int gw = F.vcu * NWAVES + F.wave, NGW = F.G * NWAVES;
    constexpr int I_IN = (NIN / 32) * (D / 64), I_OUT = (D / 32) * (D / 64), I_UQ = (QW / 32) * (512 / 64), I_UKV = (KVW / 32) * (512 / 64), I_L = I_IN + I_OUT + I_UQ + I_UKV;
    for (int it = gw; it < DEPTH * I_L; it += NGW) {
        const int l = it / I_L; int r = it % I_L;
        if (r < I_IN) { const int nb = r / (D / 64), kb = r % (D / 64); const int n0 = nb * 32; const int ns = n0 < 5632 ? (n0 < 2560 ? n0 : n0 + 64) : (2560 + (n0 - 5632));
            p0_transpose_item(F.w_in + (size_t)l * D * INW, D, INW, ns, F.win + (size_t)l * NIN_PAD * D, n0, nullptr, scr, kb * 64, F.lane, FAST_GEMM && n0 >= 5632); continue; } r -= I_IN;
        if (r < I_OUT) { const int nb = r / (D / 64), kb = r % (D / 64);
            p0_transpose_item(F.w_out + (size_t)l * D * D, D, D, nb * 32, F.wout + (size_t)l * D * D, nb * 32, nullptr, scr, kb * 64, F.lane, false); continue; } r -= I_OUT;
        if (r < I_UQ) { const int nb = r / 8, kb = r % 8;
            p0_transpose_item(F.w_uq + (size_t)l * 512 * QW, 512, QW, nb * 32, F.wuq + (size_t)l * QW * 512, nb * 32, F.qa_g + l * 512, scr, kb * 64, F.lane, FAST_GEMM && ((nb * 32) % 192) >= 128); continue; } r -= I_UQ;
        { const int nb = r / 8, kb = r % 8;
            p0_transpose_item(F.w_ukv + (size_t)l * 512 * KVW, 512, KVW, nb * 32, F.wukv + (size_t)l * KVW * 512, nb * 32, F.kva_g + l * 512, scr, kb * 64, F.lane, false); }
    }
    { const size_t per = (size_t)(NIN_PAD - NIN) * D / 8;
      for (size_t i = (size_t)blockIdx.x * NTHREADS + F.tid; i < DEPTH * per; i += (size_t)F.G * NTHREADS) { const size_t l = i / per, j = i % per;
          *(GAS v4u*)(F.win + l * NIN_PAD * D + (size_t)NIN * D + j * 8) = (v4u){0u, 0u, 0u, 0u}; } }
    for (int i = blockIdx.x * NTHREADS + F.tid; i < 1024; i += F.G * NTHREADS) { const int pos = i >> 4, fi = i & 15;
        const float inv = exp2f(-(float)fi * (13.287712379549449f / 16.f)); const float ang = (float)pos * inv;
        F.rope[i] = cosf(ang); F.rope[1024 + i] = sinf(ang); }
    __syncthreads();
    LAS float* sv = (LAS float*)F.lds;
    LAS float* red = (LAS float*)(F.lds + 32768);
    bool have_sv = false;
    for (int u = F.vcu; u < DEPTH * 192; u += F.G) {
        if (!have_sv) { for (int i = F.tid; i < 3 * D; i += NTHREADS) { const int j = i / D, k = i % D; const float cv = j < 2 ? F.c[j * D + k] : F.c_ctx[k]; sv[i] = silu_f(cv); } have_sv = true; __syncthreads(); }
        const int l = u / 192, n0 = (u % 192) * 32, col = F.lane & 31, kh = F.lane >> 5;
        const float* wp = F.w_ada + (size_t)l * D * 6144 + n0 + col;
        float a0 = 0.f, a1 = 0.f, a2 = 0.f;
#pragma unroll 8
        for (int i = 0; i < 128; ++i) { const int k = F.wave * 256 + 2 * i + kh; const float w = wp[(size_t)k * 6144]; a0 += sv[k] * w; a1 += sv[D + k] * w; a2 += sv[2 * D + k] * w; }
        a0 = sum32(a0); a1 = sum32(a1); a2 = sum32(a2);
        if (F.lane < 32) { red[(F.wave * 3 + 0) * 32 + col] = a0; red[(F.wave * 3 + 1) * 32 + col] = a1; red[(F.wave * 3 + 2) * 32 + col] = a2; }
        __syncthreads();
        if (F.tid < 96) { const int j = F.tid / 32, cc = F.tid % 32; float s = 0.f;
#pragma unroll
            for (int w = 0; w < 8; ++w) s += red[(w * 3 + j) * 32 + cc];
            F.mod[(size_t)(l * 3 + j) * 6144 + n0 + cc] = s + F.b_ada[l * 6144 + n0 + cc]; }
        __syncthreads();
    }
}

__device__ __forceinline__ void sa_phase(Frame& F, int l) {
    PHASE_IDS(F);
    const int gw = F.vcu * NWAVES + F.wave, NGW = F.G * NWAVES;
    const float* xl = (l == 0) ? F.x : F.out;
    const float* xcl = (l == 0) ? F.ctx : F.xc;
    for (int R = gw; R < MR; R += NGW) {
        const int b = row_b(R), t = R - b * TROWS; const bool isc = t >= SEQ;
        const float* src = isc ? xcl + ((size_t)b * CTX + (t - SEQ)) * D : xl + ((size_t)b * SEQ + t) * D;
        const float* md = F.mod + (size_t)(l * 3 + (isc ? 2 : b)) * 6144;
        const GAS f32x4* xr = (const GAS f32x4*)src + F.lane;
        f32x4 v[8]; float s = 0.f;
#pragma unroll
        for (int j = 0; j < 8; ++j) { v[j] = xr[64 * j]; s += (v[j].x * v[j].x + v[j].y * v[j].y) + (v[j].z * v[j].z + v[j].w * v[j].w); }
        const float rstd = 1.0f / sqrtf(wave_sum(s) * (1.f / D) + EPS);
        GAS v2u* o8 = (GAS v2u*)(F.h + (size_t)R * D) + F.lane;
#pragma unroll
        for (int j = 0; j < 8; ++j) { const int c0 = 4 * F.lane + 256 * j;
            const f32x4 g = *(const GAS f32x4*)(F.norm_g + l * D + c0), sh = *(const GAS f32x4*)(md + c0), sc = *(const GAS f32x4*)(md + D + c0);
            const f32x4 y = v[j] * rstd * g * (sc + 1.0f) + sh;
            o8[64 * j] = (v2u){pk2(y.x, y.y), pk2(y.z, y.w)}; }
    }
}
__device__ __forceinline__ void final_phase(Frame& F) {
    PHASE_IDS(F);
    const int gw = F.vcu * NWAVES + F.wave, NGW = F.G * NWAVES;
    for (int R = gw; R < NBATCH * SEQ; R += NGW) {
        GAS f32x4* xr = (GAS f32x4*)(F.out + (size_t)R * D) + F.lane;
        f32x4 v[8]; float s = 0.f;
#pragma unroll
        for (int j = 0; j < 8; ++j) { v[j] = xr[64 * j]; s += (v[j].x * v[j].x + v[j].y * v[j].y) + (v[j].z * v[j].z + v[j].w * v[j].w); }
        const float rstd = 1.0f / sqrtf(wave_sum(s) * (1.f / D) + EPS);
#pragma unroll
        for (int j = 0; j < 8; ++j) { const f32x4 g = *(const GAS f32x4*)(F.final_g + 4 * F.lane + 256 * j); xr[64 * j] = v[j] * rstd * g; }
    }
}

template <class Epi>
__device__ __forceinline__ void naive_gemm(Frame& F, const bf16* A, int lda, const bf16* Bt, int M, int N, int K, const Epi& E) {
    PHASE_IDS(F);
    LAS float* As = (LAS float*)F.lds;
    LAS float* Bs = (LAS float*)(F.lds + 32 * 132 * 4);
    const int tid = F.tid, ty = tid >> 4, tx = tid & 15;
    const int nM = M / 128, nN = N / 64;
    for (int u = F.vcu; u < nM * nN; u += F.G) {
        const int pm = u / nN, pn = u % nN, r0 = pm * 128, n0 = pn * 64;
        float acc[4][4];
#pragma unroll
        for (int i = 0; i < 4; ++i)
#pragma unroll
            for (int j = 0; j < 4; ++j) acc[i][j] = 0.f;
        for (int k0 = 0; k0 < K; k0 += 32) {
            { const int row = tid >> 2, kc = (tid & 3) * 8; const v4u w = *(const GAS v4u*)(A + (size_t)(r0 + row) * lda + k0 + kc);
              As[(kc + 0) * 132 + row] = bflo(w.x); As[(kc + 1) * 132 + row] = bfhi(w.x); As[(kc + 2) * 132 + row] = bflo(w.y); As[(kc + 3) * 132 + row] = bfhi(w.y);
              As[(kc + 4) * 132 + row] = bflo(w.z); As[(kc + 5) * 132 + row] = bfhi(w.z); As[(kc + 6) * 132 + row] = bflo(w.w); As[(kc + 7) * 132 + row] = bfhi(w.w); }
            { const int row = tid >> 3, kc = (tid & 7) * 4; const v2u w = *(const GAS v2u*)(Bt + (size_t)(n0 + row) * K + k0 + kc);
              Bs[(kc + 0) * 68 + row] = bflo(w.x); Bs[(kc + 1) * 68 + row] = bfhi(w.x); Bs[(kc + 2) * 68 + row] = bflo(w.y); Bs[(kc + 3) * 68 + row] = bfhi(w.y); }
            __syncthreads();
#pragma unroll 8
            for (int k = 0; k < 32; ++k) {
                const f32x4 a = *(const LAS f32x4*)(As + k * 132 + 4 * ty);
                float bv[4];
#pragma unroll
                for (int j = 0; j < 4; ++j) bv[j] = Bs[k * 68 + tx + 16 * j];
#pragma unroll
                for (int j = 0; j < 4; ++j) { acc[0][j] += a.x * bv[j]; acc[1][j] += a.y * bv[j]; acc[2][j] += a.z * bv[j]; acc[3][j] += a.w * bv[j]; }
            }
            __syncthreads();
        }
#pragma unroll
        for (int i = 0; i < 4; ++i) { const int R = r0 + 4 * ty + i; E.pair(F, R, n0 + tx, acc[i][0], acc[i][1]); E.pair(F, R, n0 + 32 + tx, acc[i][2], acc[i][3]); }
    }
}
__device__ __forceinline__ void st_bf(bf16* p, float v) { *(GAS bf16*)p = (bf16)f2bf(v); }
__device__ __forceinline__ void rope_pair(const float* rope, int pos, int i, float& x1, float& x2) {
    const float cs = rope[pos * 16 + i], sn = rope[1024 + pos * 16 + i]; const float a = x1 * cs - x2 * sn, b = x2 * cs + x1 * sn; x1 = a; x2 = b;
}
struct EpiWin {
    __device__ __forceinline__ float act(int n, float v) const {
        if (n < Z_GA) return gelu_f(v);
        if (n < Z_CQ) return silu_f(v);
        if (n < Z_GB) return v;
        if (n < Z_QC) return silu_f(v);
        if (n < Z_KC) return v * C_QSCALE;
        if (n < Z_GC) return v;
        return silu_f(v);
    }
    __device__ __forceinline__ void pair(Frame& F, int R, int n, float v0, float v1) const {
        if (n < ZW) { st_bf(F.z + (size_t)R * ZW + n, act(n, v0)); st_bf(F.z + (size_t)R * ZW + n + 16, act(n + 16, v1)); }
        else { const int d = n - ZW; const int b = row_b(R), t = R - b * TROWS;
            if (t < SEQ) { const int pos = d < 32 ? (t >> 6) : (t & 63); rope_pair(F.rope, pos, d & 15, v0, v1); }
            st_bf(F.kr + (size_t)R * KRW + d, v0); st_bf(F.kr + (size_t)R * KRW + d + 16, v1); }
    }
};
struct EpiKV {
    __device__ __forceinline__ void pair(Frame& F, int R, int n, float v0, float v1) const {
        const float rs = rstd512(F.rowsq, 2, R);
        st_bf(F.kv + (size_t)R * KVW + n, v0 * rs); st_bf(F.kv + (size_t)R * KVW + n + 16, v1 * rs);
    }
};
struct EpiQ {
    __device__ __forceinline__ void pair(Frame& F, int R, int n, float v0, float v1) const {
        const float rs = rstd512(F.rowsq, 1, R);
        v0 *= rs; v1 *= rs; const int d = n % 192; const int b = row_b(R), t = R - b * TROWS;
        if (d >= 128 && t < SEQ) { const int dd = d - 128; const int pos = dd < 32 ? (t >> 6) : (t & 63); rope_pair(F.rope, pos, dd & 15, v0, v1); }
        st_bf(F.q + (size_t)R * QW + n, v0 * MLA_QSCALE); st_bf(F.q + (size_t)R * QW + n + 16, v1 * MLA_QSCALE);
    }
};
struct EpiOut {
    int l;
    __device__ __forceinline__ void one(Frame& F, int R, int n, float v) const {
        const int b = row_b(R), t = R - b * TROWS;
        if (t < SEQ) { const size_t o = ((size_t)b * SEQ + t) * D + n; const float base = (l == 0) ? F.x[o] : F.out[o]; F.out[o] = base + F.mod[(size_t)(l * 3 + b) * 6144 + 2 * D + n] * v; }
        else if (l == 0) { const size_t o = ((size_t)b * CTX + (t - SEQ)) * D + n; F.xc[o] = F.ctx[o] + F.mod[(size_t)(l * 3 + 2) * 6144 + 2 * D + n] * v; }
    }
    __device__ __forceinline__ void pair(Frame& F, int R, int n, float v0, float v1) const { one(F, R, n, v0); one(F, R, n + 16, v1); }
};

__device__ __forceinline__ void rowsq_from_z(Frame& F) {
    PHASE_IDS(F);
    const int gw = F.vcu * NWAVES + F.wave, NGW = F.G * NWAVES;
    for (int R = gw; R < MR; R += NGW) {
#pragma unroll
        for (int j = 0; j < 3; ++j) { const int c0 = j == 0 ? Z_VA : (j == 1 ? Z_CQ : Z_CKV);
            const v4u w = *(const GAS v4u*)(F.z + (size_t)R * ZW + c0 + 8 * F.lane);
            float s = bflo(w.x) * bflo(w.x) + bfhi(w.x) * bfhi(w.x) + bflo(w.y) * bflo(w.y) + bfhi(w.y) * bfhi(w.y) + bflo(w.z) * bflo(w.z) + bfhi(w.z) * bfhi(w.z) + bflo(w.w) * bflo(w.w) + bfhi(w.w) * bfhi(w.w);
            s = wave_sum(s); if (F.lane < 8) F.rowsq[(size_t)(j * 8 + F.lane) * MR + R] = F.lane == 0 ? s : 0.f; }
    }
}

__device__ __forceinline__ void gmlp_naive(Frame& F, int l) {
    PHASE_IDS(F);
    LAS float* Vs = (LAS float*)F.lds;
    LAS float* Ws = (LAS float*)(F.lds + 65536);
    const int nchunk = MR / 128;
    for (int u = F.vcu; u < nchunk * 4; u += F.G) {
        const int ch = u >> 2, g = u & 3; const int R0 = ch * 128; const int t0 = R0 % TROWS;
        if (l == DEPTH - 1 && t0 >= SEQ) continue;
        for (int i = F.tid; i < 128 * 128; i += NTHREADS) { const int q = i >> 7, c = i & 127;
            const float rs = rstd512(F.rowsq, 0, R0 + q);
            Vs[i] = bf2f(F.z[(size_t)(R0 + q) * ZW + Z_VA + g * 128 + c]) * rs;
            Ws[q * 129 + c] = F.w_s[((size_t)(l * 4 + g) * 128 + q) * 128 + c]; }
        __syncthreads();
        for (int i = F.tid; i < 128 * 128; i += NTHREADS) { const int p = i >> 7, c = i & 127; float s = 0.f;
            for (int q = 0; q < 128; ++q) s += Ws[p * 129 + q] * Vs[q * 128 + c];
            const int cc = g * 128 + c; const size_t zr = (size_t)(R0 + p) * ZW;
            const float sv = s * F.sgu_g[l * 512 + cc] + F.b_s[(l * 4 + g) * 128 + p];
            st_bf(F.mix + (size_t)(R0 + p) * D + cc, bf2f(F.z[zr + Z_U + cc]) * sv * bf2f(F.z[zr + Z_GA + cc])); }
        __syncthreads();
    }
}

constexpr int NA_SC = 4352, NA_WAVE_FLOATS = NA_SC + 192;
__device__ __forceinline__ void mla_naive(Frame& F, int l) {
    PHASE_IDS(F);
    LAS float* sc = (LAS float*)F.lds + F.wave * NA_WAVE_FLOATS; LAS float* qs = sc + NA_SC;
    const int gw = F.vcu * NWAVES + F.wave, NGW = F.G * NWAVES;
    for (int it = gw; it < MR * 8; it += NGW) {
        const int R = it >> 3, hh = it & 7; const int b = row_b(R), t = R - b * TROWS; const bool isc = t >= SEQ;
        if (isc && l == DEPTH - 1) continue;
        const int kbase = b * TROWS + (isc ? SEQ : 0), nk = isc ? CTX : TROWS;
        for (int d = F.lane; d < 192; d += 64) qs[d] = bf2f(F.q[(size_t)R * QW + hh * 192 + d]);
        LDS_WAIT();
        float m = -3.0e38f;
        for (int j = F.lane; j < nk; j += 64) { const int Rk = kbase + j; float s = 0.f;
            const bf16* kn = F.kv + (size_t)Rk * KVW + hh * 256; const bf16* kr = F.kr + (size_t)Rk * KRW;
            for (int d = 0; d < 128; d += 8) { const v4u w = *(const GAS v4u*)(kn + d);
                s += qs[d] * bflo(w.x) + qs[d + 1] * bfhi(w.x) + qs[d + 2] * bflo(w.y) + qs[d + 3] * bfhi(w.y) + qs[d + 4] * bflo(w.z) + qs[d + 5] * bfhi(w.z) + qs[d + 6] * bflo(w.w) + qs[d + 7] * bfhi(w.w); }
            for (int d = 0; d < 64; d += 8) { const v4u w = *(const GAS v4u*)(kr + d);
                s += qs[128 + d] * bflo(w.x) + qs[129 + d] * bfhi(w.x) + qs[130 + d] * bflo(w.y) + qs[131 + d] * bfhi(w.y) + qs[132 + d] * bflo(w.z) + qs[133 + d] * bfhi(w.z) + qs[134 + d] * bflo(w.w) + qs[135 + d] * bfhi(w.w); }
            sc[j] = s; m = fmaxf(m, s); }
        m = wave_max(m); float sum = 0.f;
        for (int j = F.lane; j < nk; j += 64) { const float p = __builtin_amdgcn_exp2f(sc[j] - m); sc[j] = p; sum += p; }
        sum = wave_sum(sum); LDS_WAIT();
        float o0 = 0.f, o1 = 0.f;
        for (int j = 0; j < nk; ++j) { const float p = sc[j]; const unsigned w = *(const GAS unsigned*)(F.kv + (size_t)(kbase + j) * KVW + hh * 256 + 128 + 2 * F.lane); o0 += p * bflo(w); o1 += p * bfhi(w); }
        const float inv = 1.0f / sum; const unsigned gw2 = *(const GAS unsigned*)(F.z + (size_t)R * ZW + Z_GB + hh * 128 + 2 * F.lane);
        *(GAS unsigned*)(F.mix + (size_t)R * D + 512 + hh * 128 + 2 * F.lane) = pk2(o0 * inv * bflo(gw2), o1 * inv * bfhi(gw2));
        LDS_WAIT();
    }
}
__device__ __forceinline__ void natten_naive(Frame& F, int l) {
    PHASE_IDS(F);
    LAS float* sc = (LAS float*)F.lds + F.wave * NA_WAVE_FLOATS; LAS float* qs = sc + NA_SC;
    const int gw = F.vcu * NWAVES + F.wave, NGW = F.G * NWAVES;
    for (int it = gw; it < MR * 4; it += NGW) {
        const int R = it >> 2, hh = it & 3; const int b = row_b(R), t = R - b * TROWS; const bool isc = t >= SEQ;
        if (isc && l == DEPTH - 1) continue;
        const int gr = t >> 6, gc = t & 63; const int r0 = min(max(gr - 4, 0), 56), c0 = min(max(gc - 8, 0), 48);
        const int nk = isc ? CTX : 128 + CTX;
        for (int d = F.lane; d < 128; d += 64) qs[d] = bf2f(F.z[(size_t)R * ZW + Z_QC + hh * 128 + d]);
        LDS_WAIT();
        float m = -3.0e38f;
        for (int j = F.lane; j < nk; j += 64) { int Rk; float bias = 0.f;
            if (!isc && j < 128) { const int kr_ = r0 + (j >> 4), kc = c0 + (j & 15); Rk = b * TROWS + kr_ * 64 + kc;
                bias = F.rpb[((size_t)(l * 4 + hh) * 15 + (kr_ - gr + 7)) * 31 + (kc - gc + 15)] * LOG2E; }
            else Rk = b * TROWS + SEQ + (isc ? j : j - 128);
            float s = 0.f; const bf16* kp = F.z + (size_t)Rk * ZW + Z_KC + hh * 128;
            for (int d = 0; d < 128; d += 8) { const v4u w = *(const GAS v4u*)(kp + d);
                s += qs[d] * bflo(w.x) + qs[d + 1] * bfhi(w.x) + qs[d + 2] * bflo(w.y) + qs[d + 3] * bfhi(w.y) + qs[d + 4] * bflo(w.z) + qs[d + 5] * bfhi(w.z) + qs[d + 6] * bflo(w.w) + qs[d + 7] * bfhi(w.w); }
            s += bias; sc[j] = s; m = fmaxf(m, s); }
        m = wave_max(m); float sum = 0.f;
        for (int j = F.lane; j < nk; j += 64) { const float p = __builtin_amdgcn_exp2f(sc[j] - m); sc[j] = p; sum += p; }
        sum = wave_sum(sum); LDS_WAIT();
        float o0 = 0.f, o1 = 0.f;
        for (int j = 0; j < nk; ++j) { int Rk;
            if (!isc && j < 128) Rk = b * TROWS + (r0 + (j >> 4)) * 64 + c0 + (j & 15); else Rk = b * TROWS + SEQ + (isc ? j : j - 128);
            const float p = sc[j]; const unsigned w = *(const GAS unsigned*)(F.z + (size_t)Rk * ZW + Z_VC + hh * 128 + 2 * F.lane); o0 += p * bflo(w); o1 += p * bfhi(w); }
        const float inv = 1.0f / sum; const unsigned gw2 = *(const GAS unsigned*)(F.z + (size_t)R * ZW + Z_GC + hh * 128 + 2 * F.lane);
        *(GAS unsigned*)(F.mix + (size_t)R * D + 1536 + hh * 128 + 2 * F.lane) = pk2(o0 * inv * bflo(gw2), o1 * inv * bfhi(gw2));
        LDS_WAIT();
    }
}


namespace pg8 {
#define PG8_LAS __attribute__((address_space(3)))
typedef unsigned short bf16_t;
typedef short bf16x8 __attribute__((ext_vector_type(8)));
typedef unsigned u32x4 __attribute__((ext_vector_type(4)));
constexpr int BM = 256, BK = 64, HALF = 128, HTB = HALF * BK * 2, STAGE_BYTES = 8 * HTB, NXCD = 8;
__host__ __device__ __forceinline__ int lds_byte(int r, int c) { const int st = (r >> 4) * 2 + (c >> 5), rr = r & 15, cc = c & 31, ob = rr * 64 + cc * 2; return st * 1024 + (ob ^ (((ob >> 9) & 1) << 5)); }
__host__ __device__ __forceinline__ void stage_rc(int b, int& R, int& C) { const int st = b / 1024, sb = b % 1024, swz = sb ^ (((sb >> 9) & 1) << 5); R = (st >> 1) * 16 + swz / 64; C = (st & 1) * 32 + (swz % 64) / 2; }
__host__ __device__ __forceinline__ int perm32(int rho) { const int n = rho >> 4, i = rho & 15; return 8 * (i >> 2) + 4 * n + (i & 3); }
struct Unit { int pm, pn; };
struct Gemm { const bf16_t* A; const bf16_t* Bt; int lda, K; };
struct TileOrder {
    int nN, nwgL, nC, total, G, c; unsigned cmask;
    __device__ __forceinline__ void init(int nN_, unsigned cmask_, int G_, int c_) { nN = nN_; cmask = cmask_; nwgL = 32 * nN_; nC = __builtin_popcount(cmask_); total = nwgL + 2 * nC; G = G_; c = c_; }
    __device__ __forceinline__ bool next(int i, Unit& u) const {
        const int L = i * G + c; if (L >= total) return false;
        const int q = total / NXCD, r = total % NXCD, xcd = L % NXCD, off = L / NXCD; const int w = (xcd < r ? xcd * (q + 1) : r * (q + 1) + (xcd - r) * q) + off;
        if (w < nwgL) { const int nig = 8 * nN, gid = w / nig, pmL = gid * 8 + (w % nig) % 8; u.pn = (w % nig) / 8; u.pm = pmL + (pmL >= 16 ? 1 : 0); }
        else { const int wc = w - nwgL, pmc = wc / nC, k = wc % nC; unsigned m = cmask; for (int j = 0; j < k; ++j) m &= m - 1u; u.pn = __builtin_ctz(m); u.pm = pmc ? 33 : 16; }
        return true;
    }
    __device__ __forceinline__ void a_ready(const Unit&) const {}
    __device__ __forceinline__ void done(const Unit&) const {}
};
__device__ __forceinline__ unsigned cvt_pk_bf16(float lo, float hi) { unsigned r; asm volatile("v_cvt_pk_bf16_f32 %0, %1, %2" : "=v"(r) : "v"(lo), "v"(hi)); return r; }

template <class Epi, class Sched, bool ALIGN_EPI = false, bool SP2 = false>
__device__ __forceinline__ void gemm_phase(PG8_LAS unsigned char* lds, const Gemm g, const Sched& S, const Epi& E) {
    int tid_ = threadIdx.x; asm volatile("" : "+v"(tid_));
    const int tid = tid_, wid = __builtin_amdgcn_readfirstlane(tid >> 6), lane = tid & 63, wr = wid >> 2, wc = wid & 3, fr = lane & 15, fq = lane >> 4;
    const int K = g.K, nt = K / BK, lda = g.lda;
    unsigned voffA[2], voffB[2];
#pragma unroll
    for (int i = 0; i < 2; ++i) { int R, C; stage_rc(tid * 16 + i * 8192, R, C); const int Rb = Epi::PERM ? ((R & ~31) + perm32(R & 31)) : R;
        voffA[i] = (unsigned)(R * lda + C) * 2u; voffB[i] = (unsigned)(Rb * K + C) * 2u; }
    const size_t kstep = (size_t)(BK * 2);
    const size_t hstepA = (size_t)HALF * lda * 2, hstepB = (size_t)HALF * K * 2;
    const size_t tstepA = 2 * hstepA, tstepB = 2 * hstepB;
    const unsigned ldsw = (unsigned)wid * 1024u;
    const int aoff = lds_byte(wr * 64 + fr, fq * 8), boff = lds_byte(wc * 32 + fr, fq * 8);
#define PG8_SA(b, h) (((b) * 2 + (h)) * HTB)
#define PG8_SB(b, h) ((4 + (b) * 2 + (h)) * HTB)
#define PG8_STAGE(bufoff, gbase, voff) do { _Pragma("unroll") for (int _i = 0; _i < 2; ++_i) \
        __builtin_amdgcn_global_load_lds((const unsigned*)((const char*)(gbase) + (voff)[_i]), (PG8_LAS unsigned*)(lds + (bufoff) + ldsw + _i * 8192), 16, 0, 0); } while (0)
#define PG8_LDA(dst, b, h) do { _Pragma("unroll") for (int m = 0; m < 4; ++m) _Pragma("unroll") for (int k = 0; k < 2; ++k) dst[m][k] = *(const PG8_LAS bf16x8*)(lds + PG8_SA(b, h) + aoff + m * 2048 + k * 1024); } while (0)
#define PG8_LDB(dst, b, h) do { _Pragma("unroll") for (int n = 0; n < 2; ++n) _Pragma("unroll") for (int k = 0; k < 2; ++k) dst[n][k] = *(const PG8_LAS bf16x8*)(lds + PG8_SB(b, h) + boff + n * 2048 + k * 1024); } while (0)
#define PG8_MMA(ai, bj, At, Bt) do { __builtin_amdgcn_s_setprio(1); _Pragma("unroll") for (int m = 0; m < 4; ++m) _Pragma("unroll") for (int n = 0; n < 2; ++n) _Pragma("unroll") for (int k = 0; k < 2; ++k) \
        acc[ai][bj][m][n] = __builtin_amdgcn_mfma_f32_16x16x32_bf16(Bt[n][k], At[m][k], acc[ai][bj][m][n], 0, 0, 0); __builtin_amdgcn_s_setprio(0); } while (0)
#define PG8_WAIT_V(n) asm volatile("s_waitcnt vmcnt(" #n ")" ::: "memory")
#define PG8_WAIT_L(n) asm volatile("s_waitcnt lgkmcnt(" #n ")" ::: "memory")
#define PG8_BAR __builtin_amdgcn_s_barrier()
#define PG8_SCHED __builtin_amdgcn_sched_barrier(0)
    Unit cur, nxt; int ui = 0;
    if (!S.next(0, cur)) return;
    f32x4 acc[2][2][4][2];
#pragma unroll
    for (int a = 0; a < 2; ++a)
#pragma unroll
        for (int b = 0; b < 2; ++b)
#pragma unroll
            for (int m = 0; m < 4; ++m)
#pragma unroll
                for (int n = 0; n < 2; ++n) acc[a][b][m][n] = (f32x4){0.f, 0.f, 0.f, 0.f};
    bf16x8 At[4][2], B0[2][2], B1[2][2];
    const char* cA = (const char*)g.A + (size_t)cur.pm * tstepA; const char* cB = (const char*)g.Bt + (size_t)cur.pn * tstepB;
    S.a_ready(cur);
    if constexpr (SP2) {
        PG8_STAGE(PG8_SB(0, 0), cB, voffB); PG8_STAGE(PG8_SB(0, 1), cB + hstepB, voffB); PG8_STAGE(PG8_SA(0, 0), cA, voffA); PG8_STAGE(PG8_SA(0, 1), cA + hstepA, voffA);
        if (wr == 1) PG8_BAR;
        PG8_WAIT_V(2); PG8_BAR;
        PG8_STAGE(PG8_SB(1, 0), cB + kstep, voffB); PG8_STAGE(PG8_SA(1, 0), cA + kstep, voffA); PG8_STAGE(PG8_SB(1, 1), cB + hstepB + kstep, voffB);
        PG8_WAIT_V(6); PG8_BAR;
    } else {
        PG8_STAGE(PG8_SB(0, 0), cB, voffB); PG8_STAGE(PG8_SA(0, 0), cA, voffA); PG8_STAGE(PG8_SB(0, 1), cB + hstepB, voffB); PG8_STAGE(PG8_SA(0, 1), cA + hstepA, voffA);
        if (wr == 1) PG8_BAR;
        PG8_WAIT_V(4); PG8_BAR;
        PG8_STAGE(PG8_SB(1, 0), cB + kstep, voffB); PG8_STAGE(PG8_SA(1, 0), cA + kstep, voffA); PG8_STAGE(PG8_SB(1, 1), cB + hstepB + kstep, voffB);
        PG8_WAIT_V(6); PG8_BAR;
    }
    for (;;) {
        const bool has_next = S.next(ui + 1, nxt);
        const char* nA = has_next ? (const char*)g.A + (size_t)nxt.pm * tstepA : cA; const char* nB = has_next ? (const char*)g.Bt + (size_t)nxt.pn * tstepB : cB;
        for (int t = 0; t < nt; t += 2) {
            const bool last = (t == nt - 2);
            const char* a1 = cA + (size_t)(t + 1) * kstep;
            const char* a2 = last ? nA : cA + (size_t)(t + 2) * kstep; const char* b2 = last ? nB : cB + (size_t)(t + 2) * kstep;
            const char* a3 = a2 + kstep; const char* b3 = b2 + kstep;
            if (last && has_next) S.a_ready(nxt);
            if constexpr (SP2) {
            PG8_LDB(B0, 0, 0); PG8_LDB(B1, 0, 1); PG8_SCHED; PG8_LDA(At, 0, 0); PG8_STAGE(PG8_SA(1, 1), a1 + hstepA, voffA);
            PG8_WAIT_V(8); PG8_WAIT_L(0); PG8_BAR; PG8_MMA(0, 0, At, B0); PG8_MMA(0, 1, At, B1); PG8_BAR; PG8_SCHED;
            PG8_LDA(At, 0, 1); PG8_STAGE(PG8_SB(0, 0), b2, voffB); PG8_STAGE(PG8_SB(0, 1), b2 + hstepB, voffB); PG8_STAGE(PG8_SA(0, 0), a2, voffA);
            PG8_WAIT_V(8); PG8_WAIT_L(0); PG8_BAR; PG8_MMA(1, 0, At, B0); PG8_MMA(1, 1, At, B1); PG8_BAR; PG8_SCHED;
            PG8_LDB(B0, 1, 0); PG8_LDB(B1, 1, 1); PG8_SCHED; PG8_LDA(At, 1, 0); PG8_STAGE(PG8_SA(0, 1), a2 + hstepA, voffA);
            PG8_WAIT_V(8); PG8_WAIT_L(0); PG8_BAR; PG8_MMA(0, 0, At, B0); PG8_MMA(0, 1, At, B1); PG8_BAR; PG8_SCHED;
            PG8_LDA(At, 1, 1); PG8_STAGE(PG8_SB(1, 0), b3, voffB); PG8_STAGE(PG8_SB(1, 1), b3 + hstepB, voffB); PG8_STAGE(PG8_SA(1, 0), a3, voffA);
            PG8_WAIT_V(8); PG8_WAIT_L(0); PG8_BAR; PG8_MMA(1, 0, At, B0); PG8_MMA(1, 1, At, B1); PG8_BAR; PG8_SCHED;
            } else {
            PG8_LDB(B0, 0, 0); PG8_SCHED; PG8_LDA(At, 0, 0); PG8_STAGE(PG8_SA(1, 1), a1 + hstepA, voffA);
            PG8_WAIT_L(8); PG8_BAR; PG8_WAIT_L(0); PG8_MMA(0, 0, At, B0); PG8_BAR; PG8_SCHED;
            PG8_LDB(B1, 0, 1); PG8_STAGE(PG8_SB(0, 0), b2, voffB);
            PG8_BAR; PG8_WAIT_L(0); PG8_MMA(0, 1, At, B1); PG8_BAR;
            PG8_LDA(At, 0, 1); PG8_STAGE(PG8_SA(0, 0), a2, voffA);
            PG8_BAR; PG8_WAIT_L(0); PG8_MMA(1, 0, At, B0); PG8_BAR; PG8_SCHED;
            PG8_STAGE(PG8_SB(0, 1), b2 + hstepB, voffB);
            PG8_WAIT_V(6); PG8_BAR; PG8_MMA(1, 1, At, B1); PG8_BAR;
            PG8_LDB(B0, 1, 0); PG8_SCHED; PG8_LDA(At, 1, 0); PG8_STAGE(PG8_SA(0, 1), a2 + hstepA, voffA);
            PG8_WAIT_L(8); PG8_BAR; PG8_WAIT_L(0); PG8_MMA(0, 0, At, B0); PG8_BAR; PG8_SCHED;
            PG8_LDB(B1, 1, 1); PG8_STAGE(PG8_SB(1, 0), b3, voffB);
            PG8_BAR; PG8_WAIT_L(0); PG8_MMA(0, 1, At, B1); PG8_BAR;
            PG8_LDA(At, 1, 1); PG8_STAGE(PG8_SA(1, 0), a3, voffA);
            PG8_BAR; PG8_WAIT_L(0); PG8_MMA(1, 0, At, B0); PG8_BAR; PG8_SCHED;
            PG8_STAGE(PG8_SB(1, 1), b3 + hstepB, voffB);
            PG8_WAIT_V(6); PG8_BAR; PG8_MMA(1, 1, At, B1); PG8_BAR;
            }
        }
        if constexpr (ALIGN_EPI) { if (wr == 0) PG8_BAR; }
        E(acc, cur, wr, wc, fr, fq); S.done(cur);
        if (!has_next) break;
#pragma unroll
        for (int a = 0; a < 2; ++a)
#pragma unroll
            for (int b = 0; b < 2; ++b)
#pragma unroll
                for (int m = 0; m < 4; ++m)
#pragma unroll
                    for (int n = 0; n < 2; ++n) acc[a][b][m][n] = (f32x4){0.f, 0.f, 0.f, 0.f};
        cur = nxt; cA = nA; cB = nB; ++ui;
        if constexpr (ALIGN_EPI) { if (wr == 1) PG8_BAR; }
    }
    PG8_WAIT_V(0);
    if constexpr (!ALIGN_EPI) { if (wr == 0) PG8_BAR; }
    PG8_BAR;
#undef PG8_SA
#undef PG8_SB
#undef PG8_STAGE
#undef PG8_LDA
#undef PG8_LDB
#undef PG8_MMA
#undef PG8_WAIT_V
#undef PG8_WAIT_L
#undef PG8_BAR
#undef PG8_SCHED
}
}

template <int ACT> __device__ __forceinline__ float actf(float v) { if (ACT == 1) return gelu_f(v); if (ACT == 2) return silu_f(v); if (ACT == 3) return v * C_QSCALE; return v; }
struct FEpiWin {
    static constexpr bool PERM = true, AFTER_DRAIN = false;
    bf16* z; bf16* kr; float* rsq; const float* rope;
    template <int ACT, bool SQ>
    __device__ __forceinline__ void tile(const f32x4 (&acc)[2][2][4][2], int row0, int col0, float* sqp, int fq) const {
#pragma unroll
        for (int ai = 0; ai < 2; ++ai)
#pragma unroll
            for (int m = 0; m < 4; ++m) { const int row = row0 + ai * 128 + m * 16; bf16* rowp = z + (size_t)row * ZW + col0; float s = 0.f;
#pragma unroll
                for (int bj = 0; bj < 2; ++bj) { f32x4 v0 = acc[ai][bj][m][0], v1 = acc[ai][bj][m][1];
#pragma unroll
                    for (int e = 0; e < 4; ++e) { v0[e] = actf<ACT>(v0[e]); v1[e] = actf<ACT>(v1[e]); }
                    if (SQ) s += (v0[0] * v0[0] + v0[1] * v0[1]) + (v0[2] * v0[2] + v0[3] * v0[3]) + (v1[0] * v1[0] + v1[1] * v1[1]) + (v1[2] * v1[2] + v1[3] * v1[3]);
                    v4u w; w.x = pg8::cvt_pk_bf16(v0[0], v0[1]); w.y = pg8::cvt_pk_bf16(v0[2], v0[3]); w.z = pg8::cvt_pk_bf16(v1[0], v1[1]); w.w = pg8::cvt_pk_bf16(v1[2], v1[3]);
                    *(GAS v4u*)(rowp + bj * 128) = w; }
                if (SQ) { s += swz_xor<16>(s); s = sum32(s); if (fq == 0) sqp[row] = s; } }
    }
    __device__ __forceinline__ void operator()(const f32x4 (&acc)[2][2][4][2], const pg8::Unit& u, int wr, int wc, int fr, int fq) const {
        const int row0 = u.pm * 256 + wr * 64 + fr, pn = u.pn;
        if (pn < 22) {
            const int col0 = pn * 256 + wc * 32 + 8 * fq; const int slot = (pn & 1) * 4 + wc;
            if (pn < 2) tile<1, false>(acc, row0, col0, nullptr, fq);
            else if (pn < 4) tile<1, true>(acc, row0, col0, rsq + (size_t)(0 * 8 + slot) * MR, fq);
            else if (pn < 6) tile<2, false>(acc, row0, col0, nullptr, fq);
            else if (pn < 8) tile<0, true>(acc, row0, col0, rsq + (size_t)(1 * 8 + slot) * MR, fq);
            else if (pn < 10) tile<0, true>(acc, row0, col0, rsq + (size_t)(2 * 8 + slot) * MR, fq);
            else if (pn < 14) tile<2, false>(acc, row0, col0, nullptr, fq);
            else if (pn < 16) tile<3, false>(acc, row0, col0, nullptr, fq);
            else if (pn < 20) tile<0, false>(acc, row0, col0, nullptr, fq);
            else tile<2, false>(acc, row0, col0, nullptr, fq);
        } else if (wc < 2) {
#pragma unroll
            for (int ai = 0; ai < 2; ++ai)
#pragma unroll
                for (int m = 0; m < 4; ++m) { const int row = row0 + ai * 128 + m * 16; const int b = row_b(row), t = row - b * TROWS; f32x4 x1 = acc[ai][0][m][0], x2 = acc[ai][0][m][1];
                    if (t < SEQ) { const int pos = wc == 0 ? (t >> 6) : (t & 63); const f32x4 cs = *(const GAS f32x4*)(rope + pos * 16 + 4 * fq), sn = *(const GAS f32x4*)(rope + 1024 + pos * 16 + 4 * fq);
                        const f32x4 a = x1 * cs - x2 * sn, bb = x2 * cs + x1 * sn; x1 = a; x2 = bb; }
                    v4u w; w.x = pg8::cvt_pk_bf16(x1[0], x1[1]); w.y = pg8::cvt_pk_bf16(x1[2], x1[3]); w.z = pg8::cvt_pk_bf16(x2[0], x2[1]); w.w = pg8::cvt_pk_bf16(x2[2], x2[3]);
                    *(GAS v4u*)(kr + (size_t)row * KRW + wc * 32 + 8 * fq) = w; }
        }
    }
};
struct FEpiKV {
    static constexpr bool PERM = true, AFTER_DRAIN = false;
    bf16* kv; const float* rsq;
    __device__ __forceinline__ void operator()(const f32x4 (&acc)[2][2][4][2], const pg8::Unit& u, int wr, int wc, int fr, int fq) const {
        const int row0 = u.pm * 256 + wr * 64 + fr, col0 = u.pn * 256 + wc * 32 + 8 * fq;
#pragma unroll
        for (int ai = 0; ai < 2; ++ai)
#pragma unroll
            for (int m = 0; m < 4; ++m) { const int row = row0 + ai * 128 + m * 16; const float rs = rstd512(rsq, 2, row);
#pragma unroll
                for (int bj = 0; bj < 2; ++bj) { const f32x4 v0 = acc[ai][bj][m][0] * rs, v1 = acc[ai][bj][m][1] * rs;
                    v4u w; w.x = pg8::cvt_pk_bf16(v0[0], v0[1]); w.y = pg8::cvt_pk_bf16(v0[2], v0[3]); w.z = pg8::cvt_pk_bf16(v1[0], v1[1]); w.w = pg8::cvt_pk_bf16(v1[2], v1[3]);
                    *(GAS v4u*)(kv + (size_t)row * KVW + col0 + bj * 128) = w; } }
    }
};
struct FEpiQ {
    static constexpr bool PERM = true, AFTER_DRAIN = false;
    bf16* q; const float* rsq; const float* rope;
    __device__ __forceinline__ void operator()(const f32x4 (&acc)[2][2][4][2], const pg8::Unit& u, int wr, int wc, int fr, int fq) const {
        const int row0 = u.pm * 256 + wr * 64 + fr;
#pragma unroll
        for (int ai = 0; ai < 2; ++ai)
#pragma unroll
            for (int m = 0; m < 4; ++m) { const int row = row0 + ai * 128 + m * 16; const int b = row_b(row), t = row - b * TROWS; const float rs = rstd512(rsq, 1, row);
#pragma unroll
                for (int bj = 0; bj < 2; ++bj) { const int c32 = u.pn * 256 + bj * 128 + wc * 32; const int d0 = c32 % 192;
                    f32x4 x1 = acc[ai][bj][m][0] * rs, x2 = acc[ai][bj][m][1] * rs;
                    if (d0 >= 128 && t < SEQ) { const int pos = d0 == 128 ? (t >> 6) : (t & 63); const f32x4 cs = *(const GAS f32x4*)(rope + pos * 16 + 4 * fq), sn = *(const GAS f32x4*)(rope + 1024 + pos * 16 + 4 * fq);
                        const f32x4 a = x1 * cs - x2 * sn, bb = x2 * cs + x1 * sn; x1 = a; x2 = bb; }
                    x1 = x1 * MLA_QSCALE; x2 = x2 * MLA_QSCALE;
                    v4u w; w.x = pg8::cvt_pk_bf16(x1[0], x1[1]); w.y = pg8::cvt_pk_bf16(x1[2], x1[3]); w.z = pg8::cvt_pk_bf16(x2[0], x2[1]); w.w = pg8::cvt_pk_bf16(x2[2], x2[3]);
                    *(GAS v4u*)(q + (size_t)row * QW + c32 + 8 * fq) = w; } }
    }
};
struct FEpiOut {
    static constexpr bool PERM = false, AFTER_DRAIN = false;
    const float* base; float* out; const float* basec; float* outc; const float* mod; int l;
    __device__ __forceinline__ void operator()(const f32x4 (&acc)[2][2][4][2], const pg8::Unit& u, int wr, int wc, int fr, int fq) const {
        const int row0 = u.pm * 256 + wr * 64 + fr, col0 = u.pn * 256 + wc * 32 + 4 * fq;
        const int b = u.pm >= 17 ? 1 : 0; const bool isc = (u.pm == 16 || u.pm == 33);
        const float* gate = mod + (size_t)(isc ? 2 : b) * 6144 + 2 * D;
        f32x4 gv[2][2];
#pragma unroll
        for (int bj = 0; bj < 2; ++bj)
#pragma unroll
            for (int n = 0; n < 2; ++n) gv[bj][n] = *(const GAS f32x4*)(gate + col0 + bj * 128 + n * 16);
#pragma unroll
        for (int ai = 0; ai < 2; ++ai)
#pragma unroll
            for (int m = 0; m < 4; ++m) { const int row = row0 + ai * 128 + m * 16; const int t = row - b * TROWS;
                const size_t o = isc ? ((size_t)b * CTX + (t - SEQ)) * D : ((size_t)b * SEQ + t) * D; const float* bp = (isc ? basec : base) + o + col0; float* op = (isc ? outc : out) + o + col0;
#pragma unroll
                for (int bj = 0; bj < 2; ++bj)
#pragma unroll
                    for (int n = 0; n < 2; ++n) { const f32x4 bs = *(const GAS f32x4*)(bp + bj * 128 + n * 16); *(GAS f32x4*)(op + bj * 128 + n * 16) = bs + gv[bj][n] * acc[ai][bj][m][n]; } }
    }
};


namespace att {
using bf16x8 = __attribute__((ext_vector_type(8))) short;
using s16x4  = __attribute__((ext_vector_type(4))) short;
using f32x16 = __attribute__((ext_vector_type(16))) float;
using u32x4  = __attribute__((ext_vector_type(4))) unsigned;
constexpr int NW = 8, QBLK = 32, KVBLK = 64;
constexpr int SHM_V = 16384, SHM_KN = 16384, SHM_KR = 8192;
constexpr int OFF_V = 0, OFF_KN = 2 * SHM_V, OFF_KR = OFF_KN + 2 * SHM_KN, OFF_WS = 131072, SHM_ATTN = OFF_WS + NW * 64 * 4;
constexpr float THR = 6.f;
#define AT_KSWZ(row, colB) ((row) * 256 + ((colB) ^ (((row) & 15) << 4)))
#define AT_KRSWZ(row, colB) ((row) * 128 + ((colB) ^ ((((row) >> 1) & 7) << 4)))
#define AT_SBAR() __builtin_amdgcn_sched_barrier(0)
__device__ __forceinline__ int crow(int r, int hi) { return (r & 3) + 8 * (r >> 2) + 4 * hi; }
__device__ __forceinline__ unsigned cvtpk(float lo, float hi) { unsigned r; asm volatile("v_cvt_pk_bf16_f32 %0, %1, %2" : "=v"(r) : "v"(lo), "v"(hi)); return r; }
__device__ __forceinline__ bf16x8 ld8(const bf16* p) { return *reinterpret_cast<const bf16x8*>(p); }

__device__ __forceinline__ void partialSM(f32x16& p0, f32x16& p1, float& m_reg, float& mn, float& alpha) {
  float pmax = p0[0];
#pragma unroll
  for (int r = 1; r < 16; ++r) pmax = fmaxf(pmax, p0[r]);
#pragma unroll
  for (int r = 0; r < 16; ++r) pmax = fmaxf(pmax, p1[r]);
  { auto rr = __builtin_amdgcn_permlane32_swap(__float_as_uint(pmax), __float_as_uint(pmax), false, false);
    pmax = fmaxf(__uint_as_float(rr[0]), __uint_as_float(rr[1])); }
  if (__builtin_expect(__all(pmax - m_reg <= THR), 1)) { mn = m_reg; alpha = 1.f; }
  else { mn = fmaxf(m_reg, pmax); alpha = __builtin_amdgcn_exp2f(m_reg - mn); m_reg = mn; }
#pragma unroll
  for (int r = 0; r < 16; ++r) p0[r] = p0[r] - mn;
#pragma unroll
  for (int r = 0; r < 16; ++r) p1[r] = p1[r] - mn;
#pragma unroll
  for (int r = 0; r < 16; ++r) p0[r] = __builtin_amdgcn_exp2f(p0[r]);
}
__device__ __forceinline__ void finishSM(f32x16& p0, f32x16& p1, float alpha, float& l_reg, bf16x8& pa0, bf16x8& pa1, bf16x8& pa2, bf16x8& pa3) {
#pragma unroll
  for (int r = 0; r < 16; ++r) p1[r] = __builtin_amdgcn_exp2f(p1[r]);
  float ps = 0;
#pragma unroll
  for (int r = 0; r < 16; ++r) ps += p0[r];
#pragma unroll
  for (int r = 0; r < 16; ++r) ps += p1[r];
  { auto rr = __builtin_amdgcn_permlane32_swap(__float_as_uint(ps), __float_as_uint(ps), false, false);
    ps = __uint_as_float(rr[0]) + __uint_as_float(rr[1]); }
  l_reg = l_reg * alpha + ps;
#define AT_PK4(P, BASE, OUT) do { unsigned a0 = cvtpk(P[BASE + 0], P[BASE + 1]), a1 = cvtpk(P[BASE + 2], P[BASE + 3]);   \
    unsigned b0 = cvtpk(P[BASE + 4], P[BASE + 5]), b1 = cvtpk(P[BASE + 6], P[BASE + 7]);                              \
    auto r0 = __builtin_amdgcn_permlane32_swap(a0, b0, false, false); auto r1 = __builtin_amdgcn_permlane32_swap(a1, b1, false, false); \
    u32x4 w = {r0[0], r1[0], r0[1], r1[1]}; OUT = *reinterpret_cast<bf16x8*>(&w); } while (0)
  AT_PK4(p0, 0, pa0); AT_PK4(p0, 8, pa1); AT_PK4(p1, 0, pa2); AT_PK4(p1, 8, pa3);
#undef AT_PK4
}
template <bool HASR>
__device__ __forceinline__ void qkt(f32x16& p0, f32x16& p1, const char* Kn, const char* Kr, const bf16x8* qr, int r32, int hi) {
  p0 = f32x16{}; p1 = f32x16{};
#pragma unroll
  for (int d0 = 0; d0 < 8; ++d0) { const int cb = (d0 * 16 + hi * 8) * 2;
    const bf16x8 b0 = *reinterpret_cast<const bf16x8*>(Kn + AT_KSWZ(r32, cb));
    const bf16x8 b1 = *reinterpret_cast<const bf16x8*>(Kn + AT_KSWZ(32 + r32, cb));
    p0 = __builtin_amdgcn_mfma_f32_32x32x16_bf16(b0, qr[d0], p0, 0, 0, 0);
    p1 = __builtin_amdgcn_mfma_f32_32x32x16_bf16(b1, qr[d0], p1, 0, 0, 0); }
  if constexpr (HASR) {
#pragma unroll
    for (int d0 = 0; d0 < 4; ++d0) { const int cb = (d0 * 16 + hi * 8) * 2;
      const bf16x8 b0 = *reinterpret_cast<const bf16x8*>(Kr + AT_KRSWZ(r32, cb));
      const bf16x8 b1 = *reinterpret_cast<const bf16x8*>(Kr + AT_KRSWZ(32 + r32, cb));
      p0 = __builtin_amdgcn_mfma_f32_32x32x16_bf16(b0, qr[8 + d0], p0, 0, 0, 0);
      p1 = __builtin_amdgcn_mfma_f32_32x32x16_bf16(b1, qr[8 + d0], p1, 0, 0, 0); }
  }
}
__device__ __forceinline__ int v_st(int k, int c) { const int kk = (k & ~0xC) | ((k & 4) << 1) | ((k & 8) >> 1); return ((kk >> 3) * 4 + (c >> 5)) * 512 + ((kk & 7) * 32 + (c & 31)) * 2; }
__device__ __forceinline__ int v_rd_base(int lane) { return ((lane & 3) << 3) | (((lane >> 2) & 3) << 6) | (((lane >> 4) & 1) << 5) | (((lane >> 5) & 1) << 8); }
constexpr int v_rd_off(int d0, int ks, int half) { return d0 * 512 + ks * 4096 + half * 2048; }
template <int OFF> __device__ __forceinline__ s16x4 tr_read(int vb) {
  s16x4 r; asm volatile("ds_read_b64_tr_b16 %0, %1 offset:%2" : "=&v"(r) : "v"(vb), "i"(OFF) : "memory"); return r;
}
template <int D0> __device__ __forceinline__ void pv_one(f32x16& od, int vb, bf16x8 pa0, bf16x8 pa1, bf16x8 pa2, bf16x8 pa3) {
  const s16x4 l0 = tr_read<v_rd_off(D0, 0, 0)>(vb), h0 = tr_read<v_rd_off(D0, 0, 1)>(vb), l1 = tr_read<v_rd_off(D0, 1, 0)>(vb), h1 = tr_read<v_rd_off(D0, 1, 1)>(vb);
  const s16x4 l2 = tr_read<v_rd_off(D0, 2, 0)>(vb), h2 = tr_read<v_rd_off(D0, 2, 1)>(vb), l3 = tr_read<v_rd_off(D0, 3, 0)>(vb), h3 = tr_read<v_rd_off(D0, 3, 1)>(vb);
  asm volatile("s_waitcnt lgkmcnt(0)" ::: "memory"); AT_SBAR();
#define AT_PK(L, H) (bf16x8){L[0], L[1], L[2], L[3], H[0], H[1], H[2], H[3]}
  od = __builtin_amdgcn_mfma_f32_32x32x16_bf16(pa0, AT_PK(l0, h0), od, 0, 0, 0);
  od = __builtin_amdgcn_mfma_f32_32x32x16_bf16(pa1, AT_PK(l1, h1), od, 0, 0, 0);
  od = __builtin_amdgcn_mfma_f32_32x32x16_bf16(pa2, AT_PK(l2, h2), od, 0, 0, 0);
  od = __builtin_amdgcn_mfma_f32_32x32x16_bf16(pa3, AT_PK(l3, h3), od, 0, 0, 0);
#undef AT_PK
}
__device__ __forceinline__ void pv_d0(f32x16* o, int vb, bf16x8 pa0, bf16x8 pa1, bf16x8 pa2, bf16x8 pa3) {
  pv_one<0>(o[0], vb, pa0, pa1, pa2, pa3); pv_one<1>(o[1], vb, pa0, pa1, pa2, pa3); pv_one<2>(o[2], vb, pa0, pa1, pa2, pa3); pv_one<3>(o[3], vb, pa0, pa1, pa2, pa3);
}
template <bool HASR, int ldq, int ldk, int ldr, int ldo, int ldg>
__device__ __forceinline__ void attn_unit(const bf16* __restrict__ Qb, const bf16* __restrict__ Knb, const bf16* __restrict__ Vb, const bf16* __restrict__ Krb,
                                          int seq, bf16* __restrict__ Ob, const bf16* __restrict__ Gb, char* lds, int tid) {
  constexpr int NQ = HASR ? 12 : 8;
  const int wid = tid >> 6, lane = tid & 63, r32 = lane & 31, hi = lane >> 5;
  char* V_lds = lds + OFF_V; char* KN_lds = lds + OFF_KN; char* KR_lds = lds + OFF_KR;
  float* ws = (float*)(lds + OFF_WS) + wid * 64; float* li_l = ws; float* al_l = ws + 32;
  float m_reg = -1e30f, l_reg = 0; f32x16 o[4] = {}; bf16x8 qr[NQ];
  const bf16* Qw = Qb + (size_t)(wid * QBLK + r32) * ldq + hi * 8;
#pragma unroll
  for (int d0 = 0; d0 < NQ; ++d0) qr[d0] = ld8(Qw + d0 * 16);
  const int sr = tid >> 4, sc = (tid & 15) * 8, vst0 = v_st(sr, sc), vst1 = v_st(32 + sr, sc);
  const int krow = tid >> 3, kcc = (tid & 7) * 8;
  const int vb0 = (int)(uintptr_t)V_lds + v_rd_base(lane);
  bf16x8 vs0, vs1, ks0, ks1, rs0;
#define AT_SLOAD(k0) do { vs0 = ld8(&Vb[(size_t)((k0) + sr) * ldk + sc]); vs1 = ld8(&Vb[(size_t)((k0) + 32 + sr) * ldk + sc]); \
    ks0 = ld8(&Knb[(size_t)((k0) + sr) * ldk + sc]); ks1 = ld8(&Knb[(size_t)((k0) + 32 + sr) * ldk + sc]); \
    if constexpr (HASR) rs0 = ld8(&Krb[(size_t)((k0) + krow) * ldr + kcc]); } while (0)
#define AT_SWRITE(b) do { *(bf16x8*)(V_lds + (b) * SHM_V + vst0) = vs0; *(bf16x8*)(V_lds + (b) * SHM_V + vst1) = vs1; const int kc = sc * 2; \
    *(bf16x8*)(KN_lds + (b) * SHM_KN + AT_KSWZ(sr, kc)) = ks0; *(bf16x8*)(KN_lds + (b) * SHM_KN + AT_KSWZ(32 + sr, kc)) = ks1; \
    if constexpr (HASR) *(bf16x8*)(KR_lds + (b) * SHM_KR + AT_KRSWZ(krow, kcc * 2)) = rs0; } while (0)
#define AT_RESC(a) do { if (__any((a) < 1.f)) { if (hi == 0) al_l[r32] = (a); asm volatile("s_waitcnt lgkmcnt(0)" ::: "memory"); \
    _Pragma("unroll") for (int d = 0; d < 4; ++d) _Pragma("unroll") for (int r = 0; r < 16; ++r) o[d][r] *= al_l[crow(r, hi)]; } } while (0)
  f32x16 pA0, pA1, pB0, pB1; float mnA, mnB, alA, alB; bf16x8 pa0, pa1, pa2, pa3; const int NT = seq / KVBLK;
  AT_SLOAD(0); asm volatile("s_waitcnt vmcnt(0)" ::: "memory"); AT_SWRITE(0); __syncthreads();
  qkt<HASR>(pA0, pA1, KN_lds, KR_lds, qr, r32, hi); partialSM(pA0, pA1, m_reg, mnA, alA);
  AT_SLOAD(KVBLK);
  asm volatile("s_waitcnt vmcnt(0)" ::: "memory"); AT_SWRITE(1); __syncthreads();
  for (int j = 1; j + 1 < NT; j += 2) {
    AT_SBAR(); qkt<HASR>(pB0, pB1, KN_lds + SHM_KN, KR_lds + SHM_KR, qr, r32, hi);
    finishSM(pA0, pA1, alA, l_reg, pa0, pa1, pa2, pa3); AT_SBAR();
    AT_SLOAD((j + 1) * KVBLK); AT_SBAR();
    pv_d0(o, vb0, pa0, pa1, pa2, pa3); partialSM(pB0, pB1, m_reg, mnB, alB);
    __syncthreads(); asm volatile("s_waitcnt vmcnt(0)" ::: "memory"); AT_SWRITE(0);
    AT_RESC(alB); __syncthreads();
    AT_SBAR(); qkt<HASR>(pA0, pA1, KN_lds, KR_lds, qr, r32, hi);
    finishSM(pB0, pB1, alB, l_reg, pa0, pa1, pa2, pa3); AT_SBAR();
    AT_SLOAD((j + 2) * KVBLK); AT_SBAR();
    pv_d0(o, vb0 + SHM_V, pa0, pa1, pa2, pa3); partialSM(pA0, pA1, m_reg, mnA, alA);
    __syncthreads(); asm volatile("s_waitcnt vmcnt(0)" ::: "memory"); AT_SWRITE(1);
    AT_RESC(alA); __syncthreads();
  }
  AT_SBAR(); qkt<HASR>(pB0, pB1, KN_lds + SHM_KN, KR_lds + SHM_KR, qr, r32, hi);
  finishSM(pA0, pA1, alA, l_reg, pa0, pa1, pa2, pa3); AT_SBAR();
  pv_d0(o, vb0, pa0, pa1, pa2, pa3); partialSM(pB0, pB1, m_reg, mnB, alB);
  __syncthreads(); AT_RESC(alB);
  finishSM(pB0, pB1, alB, l_reg, pa0, pa1, pa2, pa3); AT_SBAR();
  pv_d0(o, vb0 + SHM_V, pa0, pa1, pa2, pa3);
  __syncthreads();
  if (hi == 0) li_l[r32] = l_reg;
  { float* stg = (float*)(lds + wid * 16384);
#pragma unroll
    for (int r = 0; r < 16; ++r) { const int orow = crow(r, hi);
#pragma unroll
      for (int d0 = 0; d0 < 4; ++d0) stg[orow * 128 + d0 * 32 + r32] = o[d0][r]; }
    asm volatile("s_waitcnt lgkmcnt(0)" ::: "memory");
    const int cc = (lane & 31) * 4;
#pragma unroll 4
    for (int it = 0; it < 16; ++it) { const int row = it * 2 + hi; const f32x4 v = *(const f32x4*)(stg + row * 128 + cc); const float rl = __builtin_amdgcn_rcpf(li_l[row]);
      const size_t grow = (size_t)(wid * QBLK + row);
      const v2u g = *(const GAS v2u*)(Gb + grow * ldg + cc);
      v2u w; w.x = cvtpk(v[0] * rl * bflo(g.x), v[1] * rl * bfhi(g.x)); w.y = cvtpk(v[2] * rl * bflo(g.y), v[3] * rl * bfhi(g.y));
      *(GAS v2u*)(Ob + grow * ldo + cc) = w; } }
  __syncthreads();
#undef AT_SLOAD
#undef AT_SWRITE
#undef AT_RESC
}
}

__device__ __forceinline__ void mla_fast(Frame& F, int l) {
    PHASE_IDS(F);
    char* lds = (char*)F.lds;
    const int nunits = 256 + (l == 0 ? 16 : 0);
    for (int u = F.vcu; u < nunits; u += F.G) {
        const int tid = fresh_tid();
        int b, hh, q0, k0, nk;
        if (u < 256) { const int bh = u >> 4; b = bh >> 3; hh = bh & 7; q0 = b * TROWS + (u & 15) * 256; k0 = b * TROWS; nk = TROWS; }
        else { const int bh = u - 256; b = bh >> 3; hh = bh & 7; q0 = b * TROWS + SEQ; k0 = q0; nk = CTX; }
        att::attn_unit<true, QW, KVW, KRW, D, ZW>(F.q + (size_t)q0 * QW + hh * 192, F.kv + (size_t)k0 * KVW + hh * 256, F.kv + (size_t)k0 * KVW + hh * 256 + 128, F.kr + (size_t)k0 * KRW,
                             nk, F.mix + (size_t)q0 * D + 512 + hh * 128, F.z + (size_t)q0 * ZW + Z_GB + hh * 128, lds, tid);
    }
}

constexpr int NPHASES = 14;
__global__ void __launch_bounds__(NTHREADS, 2) mk_fwd(Args args) {
    extern __shared__ __attribute__((aligned(16))) unsigned char lds[];
    Frame F;
    F.lds = (LAS unsigned char*)lds; F.ws = args.ws;
    F.tid = threadIdx.x; F.lane = F.tid & 63; F.wave = __builtin_amdgcn_readfirstlane(F.tid >> 6);
    F.G = gridDim.x; { const int bx = blockIdx.x; F.vcu = (F.G % 8 == 0) ? (bx % 8) * (F.G / 8) + bx / 8 : bx; }
    F.x = args.in[0]; F.c = args.in[1]; F.ctx = args.in[2]; F.c_ctx = args.in[3]; F.w_ada = args.in[4]; F.b_ada = args.in[5]; F.norm_g = args.in[6]; F.w_in = args.in[7];
    F.qa_g = args.in[8]; F.kva_g = args.in[9]; F.w_uq = args.in[10]; F.w_ukv = args.in[11]; F.sgu_g = args.in[12]; F.w_s = args.in[13]; F.b_s = args.in[14]; F.rpb = args.in[15];
    F.w_out = args.in[16]; F.final_g = args.in[17]; F.out = args.out;
    unsigned char* ws = args.ws;
    F.mod = (float*)(ws + WS_MOD); F.rope = (float*)(ws + WS_ROPE); F.rowsq = (float*)(ws + WS_ROWSQ); F.xc = (float*)(ws + WS_XC);
    F.kr = (bf16*)(ws + WS_KR); F.wuq = (bf16*)(ws + WS_WUQ); F.wukv = (bf16*)(ws + WS_WUKV); F.wout = (bf16*)(ws + WS_WOUT); F.win = (bf16*)(ws + WS_WIN);
    F.h = (bf16*)(ws + WS_H); F.z = (bf16*)(ws + WS_Z); F.q = (bf16*)(ws + WS_Q); F.kv = (bf16*)(ws + WS_KV); F.mix = (bf16*)(ws + WS_MIX);
    volatile LAS unsigned* MISC = (volatile LAS unsigned*)(F.lds + MISC_OFF);
    for (int u = F.tid; u < (LDS_BYTES - LDSCTL_OFF) / 4; u += NTHREADS) ((LAS unsigned*)(F.lds + LDSCTL_OFF))[u] = 0u;
    __syncthreads();
    XcdBarrier bar; bar.bar = (unsigned*)(ws + WS_CTL) + CW_BAR; bar.x = 0; bar.st = nullptr;
    if (MK_ONE_LAUNCH) bar = xcd_barrier_post((unsigned*)(ws + WS_CTL) + CW_BAR, MISC + 8);
    const int lo = args.ph_lo, hi = args.ph_hi;
#define IN(k) (lo <= (k) && (k) < hi)
#define SEAM(k) do { if (IN(k) && IN((k) + 1)) xcd_barrier(bar); } while (0)
    if (IN(0)) { p0_prologue(F); } SEAM(0);
    for (int l = 0; l < DEPTH; ++l) {
        const int pb = 1 + 6 * l;
        if (IN(pb + 0)) { sa_phase(F, l); } SEAM(pb + 0);
#if FAST_GEMM
        if (IN(pb + 1)) { __syncthreads();
            pg8::Gemm g{F.h, F.win + (size_t)l * NIN_PAD * D, D, D}; pg8::TileOrder S; S.init(23, l == 0 ? 0x7FFFFFu : ((3u << 8) | (0xFu << 16) | (1u << 22)), F.G, (int)blockIdx.x);
            FEpiWin E{F.z, F.kr, F.rowsq, F.rope};
            pg8::gemm_phase<FEpiWin, pg8::TileOrder, true, true>(F.lds, g, S, E); } SEAM(pb + 1);
        SEAM(pb + 2);
        if (IN(pb + 3)) { __syncthreads();
            { pg8::Gemm g{F.z + Z_CKV, F.wukv + (size_t)l * KVW * 512, ZW, 512}; pg8::TileOrder S; S.init(8, 0xFFu, F.G, (int)blockIdx.x); FEpiKV E{F.kv, F.rowsq};
              pg8::gemm_phase<FEpiKV, pg8::TileOrder, true, true>(F.lds, g, S, E); }
            { pg8::Gemm g{F.z + Z_CQ, F.wuq + (size_t)l * QW * 512, ZW, 512}; pg8::TileOrder S; S.init(6, l == 0 ? 0x3Fu : 0u, F.G, F.G - 1 - (int)blockIdx.x); FEpiQ E{F.q, F.rowsq, F.rope};
              pg8::gemm_phase<FEpiQ, pg8::TileOrder, true, true>(F.lds, g, S, E); }
            __syncthreads(); gmlp_naive(F, l);
            __syncthreads(); natten_naive(F, l);
        } SEAM(pb + 3);
#else
        if (IN(pb + 1)) { __syncthreads(); naive_gemm(F, F.h, D, F.win + (size_t)l * NIN_PAD * D, MR, NIN, D, EpiWin{}); } SEAM(pb + 1);
        if (IN(pb + 2)) { rowsq_from_z(F); } SEAM(pb + 2);
        if (IN(pb + 3)) {
            __syncthreads(); naive_gemm(F, F.z + Z_CKV, ZW, F.wukv + (size_t)l * KVW * 512, MR, KVW, 512, EpiKV{});
            __syncthreads(); naive_gemm(F, F.z + Z_CQ, ZW, F.wuq + (size_t)l * QW * 512, MR, QW, 512, EpiQ{});
            __syncthreads(); gmlp_naive(F, l);
            __syncthreads(); natten_naive(F, l);
        } SEAM(pb + 3);
#endif
#if FAST_MLA
        if (IN(pb + 4)) { __syncthreads(); mla_fast(F, l); } SEAM(pb + 4);
#else
        if (IN(pb + 4)) { __syncthreads(); mla_naive(F, l); } SEAM(pb + 4);
#endif
#if FAST_GEMM
        if (IN(pb + 5)) { __syncthreads();
            pg8::Gemm g{F.mix, F.wout + (size_t)l * D * D, D, D}; pg8::TileOrder S; S.init(8, l == 0 ? 0xFFu : 0u, F.G, (int)blockIdx.x);
            FEpiOut E{l == 0 ? F.x : F.out, F.out, F.ctx, F.xc, F.mod + (size_t)l * 3 * 6144, l};
            pg8::gemm_phase<FEpiOut, pg8::TileOrder, true, true>(F.lds, g, S, E); } SEAM(pb + 5);
#else
        if (IN(pb + 5)) { __syncthreads(); naive_gemm(F, F.mix, D, F.wout + (size_t)l * D * D, MR, D, D, EpiOut{l}); } SEAM(pb + 5);
#endif
    }
    if (IN(13)) { final_phase(F); }
#undef IN
#undef SEAM
}

extern "C" void kernel_launch(void* const* d_in, const int* in_sizes, int n_in, void* d_out, int out_size, void* d_ws, size_t ws_size, hipStream_t stream) {
    static int grid = 0;
    if (grid == 0) {
        if (n_in != 18 || in_sizes[0] != NBATCH * SEQ * D || out_size != NBATCH * SEQ * D || ws_size < WS_END) {
            fprintf(stderr, "kernel_launch: unexpected shapes: n_in %d in0 %d out %d ws %zu (need %zu)\n", n_in, n_in > 0 ? in_sizes[0] : -1, out_size, ws_size, (size_t)WS_END); grid = -1; return; }
        int dev = 0, cus = 0;
        if (hipGetDevice(&dev) != hipSuccess || hipDeviceGetAttribute(&cus, hipDeviceAttributeMultiprocessorCount, dev) != hipSuccess) { grid = -1; return; }
        if (hipFuncSetAttribute((const void*)mk_fwd, hipFuncAttributeMaxDynamicSharedMemorySize, LDS_BYTES) != hipSuccess) { fprintf(stderr, "kernel_launch: hipFuncSetAttribute failed\n"); grid = -1; return; }
        int per_cu = 0;
        if (hipOccupancyMaxActiveBlocksPerMultiprocessor(&per_cu, (const void*)mk_fwd, NTHREADS, LDS_BYTES) != hipSuccess || per_cu < 1) fprintf(stderr, "kernel_launch: occupancy query says %d\n", per_cu);
        (void)hipGetLastError();
        grid = cus;
    }
    if (grid < 0) return;
    (void)hipMemsetAsync((char*)d_ws + WS_CTL, 0, CTL_ZERO_BYTES, stream);
    Args a{};
    for (int i = 0; i < 18; ++i) a.in[i] = (const float*)d_in[i];
    a.out = (float*)d_out; a.ws = (unsigned char*)d_ws;
#if MK_ONE_LAUNCH
    a.ph_lo = 0; a.ph_hi = NPHASES;
    hipLaunchKernelGGL(mk_fwd, dim3(grid), dim3(NTHREADS), LDS_BYTES, stream, a);
#else
    for (int p = 0; p < NPHASES; ++p) { a.ph_lo = p; a.ph_hi = p + 1; hipLaunchKernelGGL(mk_fwd, dim3(grid), dim3(NTHREADS), LDS_BYTES, stream, a); }
#endif
    const hipError_t le = hipPeekAtLastError();
    if (le != hipSuccess) fprintf(stderr, "kernel_launch: launch failed: %s\n", hipGetErrorName(le));
}
```

```cpp
#include <hip/hip_runtime.h>
#include <cstdio>
#include <cstdint>

#ifndef MK_ONE_LAUNCH
#define MK_ONE_LAUNCH 1
#endif
#ifndef FAST_MLA
#define FAST_MLA 1
#endif
#ifndef FAST_SIDE
#define FAST_SIDE 1
#endif
#ifndef FAST_GEMM
#define FAST_GEMM 1
#endif

constexpr int D = 2048, NBATCH = 2, SEQ = 4096, CTX = 256, TROWS = SEQ + CTX  , MR = NBATCH * TROWS  ;
constexpr int DEPTH = 2, GRIDW = 64;
constexpr int INW = 5696;
constexpr int ZW = 5632;
constexpr int Z_U = 0, Z_VA = 512, Z_GA = 1024, Z_CQ = 1536, Z_CKV = 2048, Z_GB = 2560, Z_QC = 3584, Z_KC = 4096, Z_VC = 4608, Z_GC = 5120;
constexpr int NIN = 5696;
constexpr int QW = 1536, KVW = 2048, KRW = 64;
constexpr float EPS = 1e-6f;
constexpr float LOG2E = 1.4426950408889634f;
constexpr float MLA_QSCALE = 0.07216878364870322f * LOG2E;
constexpr float C_QSCALE = 0.08838834764831845f * LOG2E;

constexpr size_t MiB = 1u << 20;
constexpr size_t WS_CTL = 0, CTL_ZERO_BYTES = 1 * MiB;
constexpr size_t WS_MOD = 1 * MiB;
constexpr size_t WS_ROPE = WS_MOD + 256 * 1024;
constexpr size_t WS_WSB = 1536 * 1024;
constexpr size_t WS_ROWSQ = 7296 * 1024;
constexpr size_t WS_XC = 2 * MiB;
constexpr size_t WS_KR = 6 * MiB;
constexpr size_t WS_WUQ = 8 * MiB;
constexpr size_t WS_WUKV = 11 * MiB;
constexpr size_t WS_WOUT = 15 * MiB;
constexpr size_t WS_WIN = 31 * MiB;
constexpr size_t WS_H = 77 * MiB;
constexpr size_t WS_Z = 111 * MiB;
constexpr size_t WS_Q = 205 * MiB;
constexpr size_t WS_KV = 231 * MiB;
constexpr size_t WS_MIX = 265 * MiB;
constexpr size_t WS_END = 299 * MiB;
constexpr int NIN_PAD = 5888;

#define GAS __attribute__((address_space(1)))
#define LAS __attribute__((address_space(3)))
typedef unsigned short bf16;
typedef unsigned v4u __attribute__((ext_vector_type(4)));
typedef unsigned v2u __attribute__((ext_vector_type(2)));
typedef float f32x4 __attribute__((ext_vector_type(4)));
typedef GAS unsigned gu32;
#define RLX_AGENT __ATOMIC_RELAXED, __HIP_MEMORY_SCOPE_AGENT
#define LDS_WAIT() asm volatile("s_waitcnt lgkmcnt(0)" ::: "memory")
#define VM_WAIT() asm volatile("s_waitcnt vmcnt(0)" ::: "memory")
constexpr int NWAVES = 8, NTHREADS = 512;
__device__ __forceinline__ int fresh_tid(int wave0) { int l; asm volatile("v_mbcnt_lo_u32_b32 %0, -1, 0\n\tv_mbcnt_hi_u32_b32 %0, -1, %0" : "=v"(l)); return (wave0 << 6) | l; }
#define PHASE_IDS(F) do { (F).tid = fresh_tid((F).wave0); (F).lane = (F).tid & 63; (F).wave = (F).wave0; } while (0)

__device__ __forceinline__ unsigned f2bf(float f) { unsigned u = __builtin_bit_cast(unsigned, f); return (u + 0x7fffu + ((u >> 16) & 1u)) >> 16; }
__device__ __forceinline__ unsigned pk2(float lo, float hi) { return f2bf(lo) | (f2bf(hi) << 16); }
__device__ __forceinline__ float bf2f(unsigned short b) { return __builtin_bit_cast(float, (unsigned)b << 16); }
__device__ __forceinline__ float bflo(unsigned w) { return __builtin_bit_cast(float, w << 16); }
__device__ __forceinline__ float bfhi(unsigned w) { return __builtin_bit_cast(float, w & 0xffff0000u); }
__device__ __forceinline__ float fast_rcp(float x) { return __builtin_amdgcn_rcpf(x); }
__device__ __forceinline__ float silu_f(float x) { return x * fast_rcp(1.f + __builtin_amdgcn_exp2f(-LOG2E * x)); }
__device__ __forceinline__ float gelu_f(float x) { const float u = x + 0.044715f * x * x * x; return x * fast_rcp(1.f + __builtin_amdgcn_exp2f(-2.3022082f * u)); }
__device__ __forceinline__ float rstd512(const float* rsq, int j, int row) {
    float s = 0.f;
#pragma unroll
    for (int k = 0; k < 8; ++k) s += rsq[(size_t)(j * 8 + k) * MR + row];
    return 1.0f / sqrtf(s * (1.f / 512.f) + EPS);
}
template <int K> __device__ __forceinline__ float swz_xor(float v) { return __builtin_bit_cast(float, __builtin_amdgcn_ds_swizzle(__builtin_bit_cast(int, v), (K << 10) | 0x1F)); }
__device__ __forceinline__ float sum32(float v) { auto rr = __builtin_amdgcn_permlane32_swap(__float_as_uint(v), __float_as_uint(v), false, false); return __uint_as_float(rr[0]) + __uint_as_float(rr[1]); }
__device__ __forceinline__ float wave_sum(float v) {
    v += swz_xor<1>(v); v += swz_xor<2>(v); v += swz_xor<4>(v); v += swz_xor<8>(v); v += swz_xor<16>(v);
    { auto rr = __builtin_amdgcn_permlane32_swap(__float_as_uint(v), __float_as_uint(v), false, false); v = __uint_as_float(rr[0]) + __uint_as_float(rr[1]); }
    return v;
}
__device__ __forceinline__ float wave_max(float v) {
    v = fmaxf(v, swz_xor<1>(v)); v = fmaxf(v, swz_xor<2>(v)); v = fmaxf(v, swz_xor<4>(v)); v = fmaxf(v, swz_xor<8>(v)); v = fmaxf(v, swz_xor<16>(v));
    { auto rr = __builtin_amdgcn_permlane32_swap(__float_as_uint(v), __float_as_uint(v), false, false); v = fmaxf(__uint_as_float(rr[0]), __uint_as_float(rr[1])); }
    return v;
}

#define XB_TMO      128
#define XB_XCNT(j)  (256  + 64 * (j))
#define XB_XSUB(j)  (1280 + 64 * (j))
#define XB_XGEN(j)  (2304 + 64 * (j))
#define XB_TOP      3328
#define XB_TOPGEN   3392
#define XCD_BAR_WORDS 3456
#define XB_SPIN_CAP (1u << 23)
__device__ __forceinline__ unsigned xb_ld(unsigned* p)              { return __hip_atomic_load((GAS unsigned*)p, __ATOMIC_RELAXED, __HIP_MEMORY_SCOPE_AGENT); }
__device__ __forceinline__ unsigned xb_add(unsigned* p, unsigned v) { return __hip_atomic_fetch_add((GAS unsigned*)p, v, __ATOMIC_RELAXED, __HIP_MEMORY_SCOPE_AGENT); }
__device__ __forceinline__ unsigned xb_xcc_id() { return (unsigned)__builtin_amdgcn_s_getreg((3 << 11) | 20) & 0xFu; }
#define XB_SPIN(cond, bar) do { unsigned _sp = 0; while (cond) { __builtin_amdgcn_s_sleep(1); \
    if ((++_sp & 255u) == 0u) { if (xb_ld(&(bar)[XB_TMO])) break; if (_sp > XB_SPIN_CAP) { xb_add(&(bar)[XB_TMO], 1u); break; } } } } while (0)
struct XcdBarrier { unsigned* bar; unsigned x; volatile LAS unsigned* st; };
__device__ __forceinline__ XcdBarrier xcd_barrier_post(unsigned* bar, volatile LAS unsigned* st, int tid) {
    XcdBarrier b; b.bar = bar; b.x = xb_xcc_id(); b.st = st;
    if (tid == 0) (void)xb_add(&bar[XB_XCNT(b.x)], 1u);
    return b;
}
__device__ __forceinline__ void xcd_barrier_complete(unsigned* bar, unsigned x, unsigned& nloc, unsigned& nx) {
    const unsigned G = gridDim.x * gridDim.y * gridDim.z;
    unsigned sum, cnt, mine, sp = 0u;
    for (;;) {
        sum = 0u; cnt = 0u; mine = 0u;
#pragma unroll
        for (unsigned j = 0; j < 16; ++j) { const unsigned c = xb_ld(&bar[XB_XCNT(j)]); sum += c; cnt += (c > 0u) ? 1u : 0u; mine = (j == x) ? c : mine; }
        if (sum == G) break;
        __builtin_amdgcn_s_sleep(1);
        if ((++sp & 255u) == 0u) { if (xb_ld(&bar[XB_TMO])) break; if (sp > XB_SPIN_CAP) { xb_add(&bar[XB_TMO], 1u); break; } }
    }
    nloc = mine > 0u ? mine : 1u; nx = cnt > 0u ? cnt : 1u;
}
__device__ __forceinline__ void xcd_barrier(const XcdBarrier& b, int tid) {
    asm volatile("s_waitcnt vmcnt(0)" ::: "memory");
    __syncthreads();
    if (tid == 0) {
        unsigned* bar = b.bar; asm volatile("" : "+s"(bar));
        __builtin_amdgcn_s_waitcnt(0);
        unsigned nloc = b.st[0], nx = b.st[1];
        if (nloc == 0u) { xcd_barrier_complete(bar, b.x, nloc, nx); b.st[0] = nloc; b.st[1] = nx; }
        const unsigned old = xb_add(&bar[XB_XSUB(b.x)], 1u);
        const unsigned gen = old / nloc;
        if (old + 1u == (gen + 1u) * nloc) {
            __builtin_amdgcn_fence(__ATOMIC_RELEASE, "agent");
            asm volatile("s_waitcnt vmcnt(0)" ::: "memory");
            const unsigned og = xb_add(&bar[XB_TOP], 1u);
            const unsigned tg = og / nx;
            if (og + 1u == (tg + 1u) * nx) xb_add(&bar[XB_TOPGEN], 1u);
            else XB_SPIN(xb_ld(&bar[XB_TOPGEN]) == tg, bar);
            __builtin_amdgcn_fence(__ATOMIC_ACQUIRE, "agent");
            xb_add(&bar[XB_XGEN(b.x)], 1u);
            asm volatile("s_waitcnt vmcnt(0)" ::: "memory");
        } else {
            XB_SPIN(xb_ld(&bar[XB_XGEN(b.x)]) == gen, bar);
            __builtin_amdgcn_fence(__ATOMIC_ACQUIRE, "agent");
            asm volatile("s_waitcnt vmcnt(0)" ::: "memory");
        }
    }
    __syncthreads();
}

constexpr int RING_BYTES = 147456;
constexpr int LDSCTL_OFF = RING_BYTES, MISC_OFF = LDSCTL_OFF + 320;
constexpr int LDS_BYTES = 151552;
constexpr int CW_BAR = 4096;

struct Args {
    const float* in[18]; float* out; unsigned char* ws; int ph_lo, ph_hi;
};
struct Frame {
    LAS unsigned char* lds; unsigned char* ws; int tid, lane, wave, wave0, vcu, G;
    const float *x, *c, *ctx, *c_ctx, *w_ada, *b_ada, *norm_g, *w_in, *qa_g, *kva_g, *w_uq, *w_ukv, *sgu_g, *w_s, *b_s, *rpb, *w_out, *final_g;
    float* out;
    float *mod, *rope, *rowsq, *xc;
    bf16 *kr, *wuq, *wukv, *wout, *win, *h, *z, *q, *kv, *mix, *wsb;
};

__device__ __forceinline__ int row_b(int R) { return R >= TROWS ? 1 : 0; }

__device__ __forceinline__ void p0_transpose_item(const float* W, int K, int Nsrc, int nsrc0, bf16* WT, int nrow0, const float* gk, LAS float* scr, int k0, int lane, bool ropeperm) {
#pragma unroll 8
    for (int i = 0; i < 32; ++i) { const int kk = 2 * i + (lane >> 5); float v = W[(size_t)(k0 + kk) * Nsrc + nsrc0 + (lane & 31)]; if (gk) v *= gk[k0 + kk]; scr[kk * 33 + (lane & 31)] = v; }
    LDS_WAIT(); asm volatile("" ::: "memory");
    const int c = lane & 7;
#pragma unroll
    for (int j = 0; j < 4; ++j) { const int n = (lane >> 3) + 8 * j; const LAS float* s = scr + (8 * c) * 33 + n;
        v4u o; o.x = pk2(s[0 * 33], s[1 * 33]); o.y = pk2(s[2 * 33], s[3 * 33]); o.z = pk2(s[4 * 33], s[5 * 33]); o.w = pk2(s[6 * 33], s[7 * 33]);
        const int nd = ropeperm ? (8 * ((n >> 2) & 3) + 4 * (n >> 4) + (n & 3)) : n;
        *(GAS v4u*)(WT + (size_t)(nrow0 + nd) * K + k0 + 8 * c) = o; }
    LDS_WAIT(); asm volatile("" ::: "memory");
}
__device__ __forceinline__ void p0_prologue(Frame& F) {
    PHASE_IDS(F);
    LAS float* scr = (LAS float*)(F.lds + F.wave * 16384);
    const int gw = F.vcu * NWAVES + F.wave, NGW = F.G * NWAVES;
    constexpr int I_IN = (NIN / 32) * (D / 64), I_OUT = (D / 32) * (D / 64), I_UQ = (QW / 32) * (512 / 64), I_UKV = (KVW / 32) * (512 / 64), I_L = I_IN + I_OUT + I_UQ + I_UKV;
    for (int it = gw; it < DEPTH * I_L; it += NGW) {
        const int l = it / I_L; int r = it % I_L;
        if (r < I_IN) { const int nb = r / (D / 64), kb = r % (D / 64); const int n0 = nb * 32; const int ns = n0 < 5632 ? (n0 < 2560 ? n0 : n0 + 64) : (2560 + (n0 - 5632));
            p0_transpose_item(F.w_in + (size_t)l * D * INW, D, INW, ns, F.win + (size_t)l * NIN_PAD * D, n0, nullptr, scr, kb * 64, F.lane, FAST_GEMM && n0 >= 5632); continue; } r -= I_IN;
        if (r < I_OUT) { const int nb = r / (D / 64), kb = r % (D / 64);
            p0_transpose_item(F.w_out + (size_t)l * D * D, D, D, nb * 32, F.wout + (size_t)l * D * D, nb * 32, nullptr, scr, kb * 64, F.lane, false); continue; } r -= I_OUT;
        if (r < I_UQ) { const int nb = r / 8, kb = r % 8;
            p0_transpose_item(F.w_uq + (size_t)l * 512 * QW, 512, QW, nb * 32, F.wuq + (size_t)l * QW * 512, nb * 32, F.qa_g + l * 512, scr, kb * 64, F.lane, FAST_GEMM && ((nb * 32) % 192) >= 128); continue; } r -= I_UQ;
        { const int nb = r / 8, kb = r % 8;
            p0_transpose_item(F.w_ukv + (size_t)l * 512 * KVW, 512, KVW, nb * 32, F.wukv + (size_t)l * KVW * 512, nb * 32, F.kva_g + l * 512, scr, kb * 64, F.lane, false); }
    }
    { const size_t per = (size_t)(NIN_PAD - NIN) * D / 8;
      for (size_t i = (size_t)blockIdx.x * NTHREADS + F.tid; i < DEPTH * per; i += (size_t)F.G * NTHREADS) { const size_t l = i / per, j = i % per;
          *(GAS v4u*)(F.win + l * NIN_PAD * D + (size_t)NIN * D + j * 8) = (v4u){0u, 0u, 0u, 0u}; } }
    for (int i = blockIdx.x * NTHREADS + F.tid; i < DEPTH * 4 * 128 * 128 / 4; i += F.G * NTHREADS) { const f32x4 v = *(const GAS f32x4*)(F.w_s + 4 * (size_t)i);
        *(GAS v2u*)(F.wsb + 4 * (size_t)i) = (v2u){pk2(v.x, v.y), pk2(v.z, v.w)}; }
    for (int i = blockIdx.x * NTHREADS + F.tid; i < 1024; i += F.G * NTHREADS) { const int pos = i >> 4, fi = i & 15;
        const float inv = exp2f(-(float)fi * (13.287712379549449f / 16.f)); const float ang = (float)pos * inv;
        F.rope[i] = cosf(ang); F.rope[1024 + i] = sinf(ang); }
    __syncthreads();
    LAS float* sv = (LAS float*)F.lds;
    LAS float* red = (LAS float*)(F.lds + 32768);
    bool have_sv = false;
    for (int u = F.vcu; u < DEPTH * 192; u += F.G) {
        if (!have_sv) { for (int i = F.tid; i < 3 * D; i += NTHREADS) { const int j = i / D, k = i % D; const float cv = j < 2 ? F.c[j * D + k] : F.c_ctx[k]; sv[i] = silu_f(cv); } have_sv = true; __syncthreads(); }
        const int l = u / 192, n0 = (u % 192) * 32, col = F.lane & 31, kh = F.lane >> 5;
        const float* wp = F.w_ada + (size_t)l * D * 6144 + n0 + col;
        float a0 = 0.f, a1 = 0.f, a2 = 0.f;
#pragma unroll 8
        for (int i = 0; i < 128; ++i) { const int k = F.wave * 256 + 2 * i + kh; const float w = wp[(size_t)k * 6144]; a0 += sv[k] * w; a1 += sv[D + k] * w; a2 += sv[2 * D + k] * w; }
        a0 = sum32(a0); a1 = sum32(a1); a2 = sum32(a2);
        if (F.lane < 32) { red[(F.wave * 3 + 0) * 32 + col] = a0; red[(F.wave * 3 + 1) * 32 + col] = a1; red[(F.wave * 3 + 2) * 32 + col] = a2; }
        __syncthreads();
        if (F.tid < 96) { const int j = F.tid / 32, cc = F.tid % 32; float s = 0.f;
#pragma unroll
            for (int w = 0; w < 8; ++w) s += red[(w * 3 + j) * 32 + cc];
            F.mod[(size_t)(l * 3 + j) * 6144 + n0 + cc] = s + F.b_ada[l * 6144 + n0 + cc]; }
        __syncthreads();
    }
}

__device__ __forceinline__ void sa_phase(Frame& F, int l) {
    PHASE_IDS(F);
    const int gw = F.vcu * NWAVES + F.wave, NGW = F.G * NWAVES;
    const float* xl = (l == 0) ? F.x : F.out;
    const float* xcl = (l == 0) ? F.ctx : F.xc;
    for (int R = gw; R < MR; R += NGW) {
        const int b = row_b(R), t = R - b * TROWS; const bool isc = t >= SEQ;
        const float* src = isc ? xcl + ((size_t)b * CTX + (t - SEQ)) * D : xl + ((size_t)b * SEQ + t) * D;
        const float* md = F.mod + (size_t)(l * 3 + (isc ? 2 : b)) * 6144;
        const GAS f32x4* xr = (const GAS f32x4*)src + F.lane;
        f32x4 v[8]; float s = 0.f;
#pragma unroll
        for (int j = 0; j < 8; ++j) { v[j] = xr[64 * j]; s += (v[j].x * v[j].x + v[j].y * v[j].y) + (v[j].z * v[j].z + v[j].w * v[j].w); }
        const float rstd = 1.0f / sqrtf(wave_sum(s) * (1.f / D) + EPS);
        GAS v2u* o8 = (GAS v2u*)(F.h + (size_t)R * D) + F.lane;
#pragma unroll
        for (int j = 0; j < 8; ++j) { const int c0 = 4 * F.lane + 256 * j;
            const f32x4 g = *(const GAS f32x4*)(F.norm_g + l * D + c0), sh = *(const GAS f32x4*)(md + c0), sc = *(const GAS f32x4*)(md + D + c0);
            const f32x4 y = v[j] * rstd * g * (sc + 1.0f) + sh;
            o8[64 * j] = (v2u){pk2(y.x, y.y), pk2(y.z, y.w)}; }
    }
}
__device__ __forceinline__ void final_phase(Frame& F) {
    PHASE_IDS(F);
    const int gw = F.vcu * NWAVES + F.wave, NGW = F.G * NWAVES;
    for (int R = gw; R < NBATCH * SEQ; R += NGW) {
        GAS f32x4* xr = (GAS f32x4*)(F.out + (size_t)R * D) + F.lane;
        f32x4 v[8]; float s = 0.f;
#pragma unroll
        for (int j = 0; j < 8; ++j) { v[j] = xr[64 * j]; s += (v[j].x * v[j].x + v[j].y * v[j].y) + (v[j].z * v[j].z + v[j].w * v[j].w); }
        const float rstd = 1.0f / sqrtf(wave_sum(s) * (1.f / D) + EPS);
#pragma unroll
        for (int j = 0; j < 8; ++j) { const f32x4 g = *(const GAS f32x4*)(F.final_g + 4 * F.lane + 256 * j); xr[64 * j] = v[j] * rstd * g; }
    }
}

template <class Epi>
__device__ __forceinline__ void naive_gemm(Frame& F, const bf16* A, int lda, const bf16* Bt, int M, int N, int K, const Epi& E) {
    PHASE_IDS(F);
    LAS float* As = (LAS float*)F.lds;
    LAS float* Bs = (LAS float*)(F.lds + 32 * 132 * 4);
    const int tid = F.tid, ty = tid >> 4, tx = tid & 15;
    const int nM = M / 128, nN = N / 64;
    for (int u = F.vcu; u < nM * nN; u += F.G) {
        const int pm = u / nN, pn = u % nN, r0 = pm * 128, n0 = pn * 64;
        float acc[4][4];
#pragma unroll
        for (int i = 0; i < 4; ++i)
#pragma unroll
            for (int j = 0; j < 4; ++j) acc[i][j] = 0.f;
        for (int k0 = 0; k0 < K; k0 += 32) {
            { const int row = tid >> 2, kc = (tid & 3) * 8; const v4u w = *(const GAS v4u*)(A + (size_t)(r0 + row) * lda + k0 + kc);
              As[(kc + 0) * 132 + row] = bflo(w.x); As[(kc + 1) * 132 + row] = bfhi(w.x); As[(kc + 2) * 132 + row] = bflo(w.y); As[(kc + 3) * 132 + row] = bfhi(w.y);
              As[(kc + 4) * 132 + row] = bflo(w.z); As[(kc + 5) * 132 + row] = bfhi(w.z); As[(kc + 6) * 132 + row] = bflo(w.w); As[(kc + 7) * 132 + row] = bfhi(w.w); }
            { const int row = tid >> 3, kc = (tid & 7) * 4; const v2u w = *(const GAS v2u*)(Bt + (size_t)(n0 + row) * K + k0 + kc);
              Bs[(kc + 0) * 68 + row] = bflo(w.x); Bs[(kc + 1) * 68 + row] = bfhi(w.x); Bs[(kc + 2) * 68 + row] = bflo(w.y); Bs[(kc + 3) * 68 + row] = bfhi(w.y); }
            __syncthreads();
#pragma unroll 8
            for (int k = 0; k < 32; ++k) {
                const f32x4 a = *(const LAS f32x4*)(As + k * 132 + 4 * ty);
                float bv[4];
#pragma unroll
                for (int j = 0; j < 4; ++j) bv[j] = Bs[k * 68 + tx + 16 * j];
#pragma unroll
                for (int j = 0; j < 4; ++j) { acc[0][j] += a.x * bv[j]; acc[1][j] += a.y * bv[j]; acc[2][j] += a.z * bv[j]; acc[3][j] += a.w * bv[j]; }
            }
            __syncthreads();
        }
#pragma unroll
        for (int i = 0; i < 4; ++i) { const int R = r0 + 4 * ty + i; E.pair(F, R, n0 + tx, acc[i][0], acc[i][1]); E.pair(F, R, n0 + 32 + tx, acc[i][2], acc[i][3]); }
    }
}
__device__ __forceinline__ void st_bf(bf16* p, float v) { *(GAS bf16*)p = (bf16)f2bf(v); }
__device__ __forceinline__ void rope_pair(const float* rope, int pos, int i, float& x1, float& x2) {
    const float cs = rope[pos * 16 + i], sn = rope[1024 + pos * 16 + i]; const float a = x1 * cs - x2 * sn, b = x2 * cs + x1 * sn; x1 = a; x2 = b;
}
struct EpiWin {
    __device__ __forceinline__ float act(int n, float v) const {
        if (n < Z_GA) return gelu_f(v);
        if (n < Z_CQ) return silu_f(v);
        if (n < Z_GB) return v;
        if (n < Z_QC) return silu_f(v);
        if (n < Z_KC) return v * C_QSCALE;
        if (n < Z_GC) return v;
        return silu_f(v);
    }
    __device__ __forceinline__ void pair(Frame& F, int R, int n, float v0, float v1) const {
        if (n < ZW) { st_bf(F.z + (size_t)R * ZW + n, act(n, v0)); st_bf(F.z + (size_t)R * ZW + n + 16, act(n + 16, v1)); }
        else { const int d = n - ZW; const int b = row_b(R), t = R - b * TROWS;
            if (t < SEQ) { const int pos = d < 32 ? (t >> 6) : (t & 63); rope_pair(F.rope, pos, d & 15, v0, v1); }
            st_bf(F.kr + (size_t)R * KRW + d, v0); st_bf(F.kr + (size_t)R * KRW + d + 16, v1); }
    }
};
struct EpiKV {
    __device__ __forceinline__ void pair(Frame& F, int R, int n, float v0, float v1) const {
        const float rs = rstd512(F.rowsq, 2, R);
        st_bf(F.kv + (size_t)R * KVW + n, v0 * rs); st_bf(F.kv + (size_t)R * KVW + n + 16, v1 * rs);
    }
};
struct EpiQ {
    __device__ __forceinline__ void pair(Frame& F, int R, int n, float v0, float v1) const {
        const float rs = rstd512(F.rowsq, 1, R);
        v0 *= rs; v1 *= rs; const int d = n % 192; const int b = row_b(R), t = R - b * TROWS;
        if (d >= 128 && t < SEQ) { const int dd = d - 128; const int pos = dd < 32 ? (t >> 6) : (t & 63); rope_pair(F.rope, pos, dd & 15, v0, v1); }
        st_bf(F.q + (size_t)R * QW + n, v0 * MLA_QSCALE); st_bf(F.q + (size_t)R * QW + n + 16, v1 * MLA_QSCALE);
    }
};
struct EpiOut {
    int l;
    __device__ __forceinline__ void one(Frame& F, int R, int n, float v) const {
        const int b = row_b(R), t = R - b * TROWS;
        if (t < SEQ) { const size_t o = ((size_t)b * SEQ + t) * D + n; const float base = (l == 0) ? F.x[o] : F.out[o]; F.out[o] = base + F.mod[(size_t)(l * 3 + b) * 6144 + 2 * D + n] * v; }
        else if (l == 0) { const size_t o = ((size_t)b * CTX + (t - SEQ)) * D + n; F.xc[o] = F.ctx[o] + F.mod[(size_t)(l * 3 + 2) * 6144 + 2 * D + n] * v; }
    }
    __device__ __forceinline__ void pair(Frame& F, int R, int n, float v0, float v1) const { one(F, R, n, v0); one(F, R, n + 16, v1); }
};

__device__ __forceinline__ void rowsq_from_z(Frame& F) {
    PHASE_IDS(F);
    const int gw = F.vcu * NWAVES + F.wave, NGW = F.G * NWAVES;
    for (int R = gw; R < MR; R += NGW) {
#pragma unroll
        for (int j = 0; j < 3; ++j) { const int c0 = j == 0 ? Z_VA : (j == 1 ? Z_CQ : Z_CKV);
            const v4u w = *(const GAS v4u*)(F.z + (size_t)R * ZW + c0 + 8 * F.lane);
            float s = bflo(w.x) * bflo(w.x) + bfhi(w.x) * bfhi(w.x) + bflo(w.y) * bflo(w.y) + bfhi(w.y) * bfhi(w.y) + bflo(w.z) * bflo(w.z) + bfhi(w.z) * bfhi(w.z) + bflo(w.w) * bflo(w.w) + bfhi(w.w) * bfhi(w.w);
            s = wave_sum(s); if (F.lane < 8) F.rowsq[(size_t)(j * 8 + F.lane) * MR + R] = F.lane == 0 ? s : 0.f; }
    }
}

__device__ __forceinline__ void gmlp_naive(Frame& F, int l) {
    PHASE_IDS(F);
    LAS float* Vs = (LAS float*)F.lds;
    LAS float* Ws = (LAS float*)(F.lds + 65536);
    const int nchunk = MR / 128;
    for (int u = F.vcu; u < nchunk * 4; u += F.G) {
        const int ch = u >> 2, g = u & 3; const int R0 = ch * 128; const int t0 = R0 % TROWS;
        if (l == DEPTH - 1 && t0 >= SEQ) continue;
        for (int i = F.tid; i < 128 * 128; i += NTHREADS) { const int q = i >> 7, c = i & 127;
            const float rs = rstd512(F.rowsq, 0, R0 + q);
            Vs[i] = bf2f(F.z[(size_t)(R0 + q) * ZW + Z_VA + g * 128 + c]) * rs;
            Ws[q * 129 + c] = F.w_s[((size_t)(l * 4 + g) * 128 + q) * 128 + c]; }
        __syncthreads();
        for (int i = F.tid; i < 128 * 128; i += NTHREADS) { const int p = i >> 7, c = i & 127; float s = 0.f;
            for (int q = 0; q < 128; ++q) s += Ws[p * 129 + q] * Vs[q * 128 + c];
            const int cc = g * 128 + c; const size_t zr = (size_t)(R0 + p) * ZW;
            const float sv = s * F.sgu_g[l * 512 + cc] + F.b_s[(l * 4 + g) * 128 + p];
            st_bf(F.mix + (size_t)(R0 + p) * D + cc, bf2f(F.z[zr + Z_U + cc]) * sv * bf2f(F.z[zr + Z_GA + cc])); }
        __syncthreads();
    }
}

constexpr int NA_SC = 4352, NA_WAVE_FLOATS = NA_SC + 192;
__device__ __forceinline__ void mla_naive(Frame& F, int l) {
    PHASE_IDS(F);
    LAS float* sc = (LAS float*)F.lds + F.wave * NA_WAVE_FLOATS; LAS float* qs = sc + NA_SC;
    const int gw = F.vcu * NWAVES + F.wave, NGW = F.G * NWAVES;
    for (int it = gw; it < MR * 8; it += NGW) {
        const int R = it >> 3, hh = it & 7; const int b = row_b(R), t = R - b * TROWS; const bool isc = t >= SEQ;
        if (isc && l == DEPTH - 1) continue;
        const int kbase = b * TROWS + (isc ? SEQ : 0), nk = isc ? CTX : TROWS;
        for (int d = F.lane; d < 192; d += 64) qs[d] = bf2f(F.q[(size_t)R * QW + hh * 192 + d]);
        LDS_WAIT();
        float m = -3.0e38f;
        for (int j = F.lane; j < nk; j += 64) { const int Rk = kbase + j; float s = 0.f;
            const bf16* kn = F.kv + (size_t)Rk * KVW + hh * 256; const bf16* kr = F.kr + (size_t)Rk * KRW;
            for (int d = 0; d < 128; d += 8) { const v4u w = *(const GAS v4u*)(kn + d);
                s += qs[d] * bflo(w.x) + qs[d + 1] * bfhi(w.x) + qs[d + 2] * bflo(w.y) + qs[d + 3] * bfhi(w.y) + qs[d + 4] * bflo(w.z) + qs[d + 5] * bfhi(w.z) + qs[d + 6] * bflo(w.w) + qs[d + 7] * bfhi(w.w); }
            for (int d = 0; d < 64; d += 8) { const v4u w = *(const GAS v4u*)(kr + d);
                s += qs[128 + d] * bflo(w.x) + qs[129 + d] * bfhi(w.x) + qs[130 + d] * bflo(w.y) + qs[131 + d] * bfhi(w.y) + qs[132 + d] * bflo(w.z) + qs[133 + d] * bfhi(w.z) + qs[134 + d] * bflo(w.w) + qs[135 + d] * bfhi(w.w); }
            sc[j] = s; m = fmaxf(m, s); }
        m = wave_max(m); float sum = 0.f;
        for (int j = F.lane; j < nk; j += 64) { const float p = __builtin_amdgcn_exp2f(sc[j] - m); sc[j] = p; sum += p; }
        sum = wave_sum(sum); LDS_WAIT();
        float o0 = 0.f, o1 = 0.f;
        for (int j = 0; j < nk; ++j) { const float p = sc[j]; const unsigned w = *(const GAS unsigned*)(F.kv + (size_t)(kbase + j) * KVW + hh * 256 + 128 + 2 * F.lane); o0 += p * bflo(w); o1 += p * bfhi(w); }
        const float inv = 1.0f / sum; const unsigned gw2 = *(const GAS unsigned*)(F.z + (size_t)R * ZW + Z_GB + hh * 128 + 2 * F.lane);
        *(GAS unsigned*)(F.mix + (size_t)R * D + 512 + hh * 128 + 2 * F.lane) = pk2(o0 * inv * bflo(gw2), o1 * inv * bfhi(gw2));
        LDS_WAIT();
    }
}
__device__ __forceinline__ void natten_naive(Frame& F, int l) {
    PHASE_IDS(F);
    LAS float* sc = (LAS float*)F.lds + F.wave * NA_WAVE_FLOATS; LAS float* qs = sc + NA_SC;
    const int gw = F.vcu * NWAVES + F.wave, NGW = F.G * NWAVES;
    for (int it = gw; it < MR * 4; it += NGW) {
        const int R = it >> 2, hh = it & 3; const int b = row_b(R), t = R - b * TROWS; const bool isc = t >= SEQ;
        if (isc && l == DEPTH - 1) continue;
        const int gr = t >> 6, gc = t & 63; const int r0 = min(max(gr - 4, 0), 56), c0 = min(max(gc - 8, 0), 48);
        const int nk = isc ? CTX : 128 + CTX;
        for (int d = F.lane; d < 128; d += 64) qs[d] = bf2f(F.z[(size_t)R * ZW + Z_QC + hh * 128 + d]);
        LDS_WAIT();
        float m = -3.0e38f;
        for (int j = F.lane; j < nk; j += 64) { int Rk; float bias = 0.f;
            if (!isc && j < 128) { const int kr_ = r0 + (j >> 4), kc = c0 + (j & 15); Rk = b * TROWS + kr_ * 64 + kc;
                bias = F.rpb[((size_t)(l * 4 + hh) * 15 + (kr_ - gr + 7)) * 31 + (kc - gc + 15)] * LOG2E; }
            else Rk = b * TROWS + SEQ + (isc ? j : j - 128);
            float s = 0.f; const bf16* kp = F.z + (size_t)Rk * ZW + Z_KC + hh * 128;
            for (int d = 0; d < 128; d += 8) { const v4u w = *(const GAS v4u*)(kp + d);
                s += qs[d] * bflo(w.x) + qs[d + 1] * bfhi(w.x) + qs[d + 2] * bflo(w.y) + qs[d + 3] * bfhi(w.y) + qs[d + 4] * bflo(w.z) + qs[d + 5] * bfhi(w.z) + qs[d + 6] * bflo(w.w) + qs[d + 7] * bfhi(w.w); }
            s += bias; sc[j] = s; m = fmaxf(m, s); }
        m = wave_max(m); float sum = 0.f;
        for (int j = F.lane; j < nk; j += 64) { const float p = __builtin_amdgcn_exp2f(sc[j] - m); sc[j] = p; sum += p; }
        sum = wave_sum(sum); LDS_WAIT();
        float o0 = 0.f, o1 = 0.f;
        for (int j = 0; j < nk; ++j) { int Rk;
            if (!isc && j < 128) Rk = b * TROWS + (r0 + (j >> 4)) * 64 + c0 + (j & 15); else Rk = b * TROWS + SEQ + (isc ? j : j - 128);
            const float p = sc[j]; const unsigned w = *(const GAS unsigned*)(F.z + (size_t)Rk * ZW + Z_VC + hh * 128 + 2 * F.lane); o0 += p * bflo(w); o1 += p * bfhi(w); }
        const float inv = 1.0f / sum; const unsigned gw2 = *(const GAS unsigned*)(F.z + (size_t)R * ZW + Z_GC + hh * 128 + 2 * F.lane);
        *(GAS unsigned*)(F.mix + (size_t)R * D + 1536 + hh * 128 + 2 * F.lane) = pk2(o0 * inv * bflo(gw2), o1 * inv * bfhi(gw2));
        LDS_WAIT();
    }
}


namespace pg8 {
#define PG8_LAS __attribute__((address_space(3)))
typedef unsigned short bf16_t;
typedef short bf16x8 __attribute__((ext_vector_type(8)));
typedef unsigned u32x4 __attribute__((ext_vector_type(4)));
constexpr int BM = 256, BK = 64, HALF = 128, HTB = HALF * BK * 2, STAGE_BYTES = 8 * HTB, NXCD = 8;
__host__ __device__ __forceinline__ int lds_byte(int r, int c) { const int st = (r >> 4) * 2 + (c >> 5), rr = r & 15, cc = c & 31, ob = rr * 64 + cc * 2; return st * 1024 + (ob ^ (((ob >> 9) & 1) << 5)); }
__host__ __device__ __forceinline__ void stage_rc(int b, int& R, int& C) { const int st = b / 1024, sb = b % 1024, swz = sb ^ (((sb >> 9) & 1) << 5); R = (st >> 1) * 16 + swz / 64; C = (st & 1) * 32 + (swz % 64) / 2; }
__host__ __device__ __forceinline__ int perm32(int rho) { const int n = rho >> 4, i = rho & 15; return 8 * (i >> 2) + 4 * n + (i & 3); }
struct Unit { int pm, pn; };
struct Gemm { const bf16_t* A; const bf16_t* Bt; int lda, K; };
struct TileOrder {
    int nN, nwgL, nC, total, G, c; unsigned cmask;
    __device__ __forceinline__ void init(int nN_, unsigned cmask_, int G_, int c_) { nN = nN_; cmask = cmask_; nwgL = 32 * nN_; nC = __builtin_popcount(cmask_); total = nwgL + 2 * nC; G = G_; c = c_; }
    __device__ __forceinline__ bool next(int i, Unit& u) const {
        const int L = i * G + c; if (L >= total) return false;
        const int q = total / NXCD, r = total % NXCD, xcd = L % NXCD, off = L / NXCD; const int w = (xcd < r ? xcd * (q + 1) : r * (q + 1) + (xcd - r) * q) + off;
        if (w < nwgL) { const int nig = 8 * nN, gid = w / nig, pmL = gid * 8 + (w % nig) % 8; u.pn = (w % nig) / 8; u.pm = pmL + (pmL >= 16 ? 1 : 0); }
        else { const int wc = w - nwgL, pmc = wc / nC, k = wc % nC; unsigned m = cmask; for (int j = 0; j < k; ++j) m &= m - 1u; u.pn = __builtin_ctz(m); u.pm = pmc ? 33 : 16; }
        return true;
    }
    __device__ __forceinline__ void a_ready(const Unit&) const {}
    __device__ __forceinline__ void done(const Unit&) const {}
};
__device__ __forceinline__ unsigned cvt_pk_bf16(float lo, float hi) { unsigned r; asm volatile("v_cvt_pk_bf16_f32 %0, %1, %2" : "=v"(r) : "v"(lo), "v"(hi)); return r; }

template <class Epi, class Sched, bool ALIGN_EPI = false, bool SP2 = false>
__device__ __forceinline__ void gemm_phase(PG8_LAS unsigned char* lds, const Gemm g, const Sched& S, const Epi& E, const int tid) {
    const int wid = __builtin_amdgcn_readfirstlane(tid >> 6), lane = tid & 63, wr = wid >> 2, wc = wid & 3, fr = lane & 15, fq = lane >> 4;
    const int K = g.K, nt = K / BK, lda = g.lda;
    unsigned voffA[2], voffB[2];
#pragma unroll
    for (int i = 0; i < 2; ++i) { int R, C; stage_rc(tid * 16 + i * 8192, R, C); const int Rb = Epi::PERM ? ((R & ~31) + perm32(R & 31)) : R;
        voffA[i] = (unsigned)(R * lda + C) * 2u; voffB[i] = (unsigned)(Rb * K + C) * 2u; }
    const size_t kstep = (size_t)(BK * 2);
    const size_t hstepA = (size_t)HALF * lda * 2, hstepB = (size_t)HALF * K * 2;
    const size_t tstepA = 2 * hstepA, tstepB = 2 * hstepB;
    const unsigned ldsw = (unsigned)wid * 1024u;
    const int aoff = lds_byte(wr * 64 + fr, fq * 8), boff = lds_byte(wc * 32 + fr, fq * 8);
#define PG8_SA(b, h) (((b) * 2 + (h)) * HTB)
#define PG8_SB(b, h) ((4 + (b) * 2 + (h)) * HTB)
#define PG8_STAGE(bufoff, gbase, voff) do { _Pragma("unroll") for (int _i = 0; _i < 2; ++_i) \
        __builtin_amdgcn_global_load_lds((const unsigned*)((const char*)(gbase) + (voff)[_i]), (PG8_LAS unsigned*)(lds + (bufoff) + ldsw + _i * 8192), 16, 0, 0); } while (0)
#define PG8_LDA(dst, b, h) do { _Pragma("unroll") for (int m = 0; m < 4; ++m) _Pragma("unroll") for (int k = 0; k < 2; ++k) dst[m][k] = *(const PG8_LAS bf16x8*)(lds + PG8_SA(b, h) + aoff + m * 2048 + k * 1024); } while (0)
#define PG8_LDB(dst, b, h) do { _Pragma("unroll") for (int n = 0; n < 2; ++n) _Pragma("unroll") for (int k = 0; k < 2; ++k) dst[n][k] = *(const PG8_LAS bf16x8*)(lds + PG8_SB(b, h) + boff + n * 2048 + k * 1024); } while (0)
#define PG8_MMA(ai, bj, At, Bt) do { __builtin_amdgcn_s_setprio(1); _Pragma("unroll") for (int m = 0; m < 4; ++m) _Pragma("unroll") for (int n = 0; n < 2; ++n) _Pragma("unroll") for (int k = 0; k < 2; ++k) \
        acc[ai][bj][m][n] = __builtin_amdgcn_mfma_f32_16x16x32_bf16(Bt[n][k], At[m][k], acc[ai][bj][m][n], 0, 0, 0); __builtin_amdgcn_s_setprio(0); } while (0)
#define PG8_WAIT_V(n) asm volatile("s_waitcnt vmcnt(" #n ")" ::: "memory")
#define PG8_WAIT_L(n) asm volatile("s_waitcnt lgkmcnt(" #n ")" ::: "memory")
#define PG8_BAR __builtin_amdgcn_s_barrier()
#define PG8_SCHED __builtin_amdgcn_sched_barrier(0)
    Unit cur, nxt; int ui = 0;
    if (!S.next(0, cur)) return;
    f32x4 acc[2][2][4][2];
#pragma unroll
    for (int a = 0; a < 2; ++a)
#pragma unroll
        for (int b = 0; b < 2; ++b)
#pragma unroll
            for (int m = 0; m < 4; ++m)
#pragma unroll
                for (int n = 0; n < 2; ++n) acc[a][b][m][n] = (f32x4){0.f, 0.f, 0.f, 0.f};
    bf16x8 At[4][2], B0[2][2], B1[2][2];
    const char* cA = (const char*)g.A + (size_t)cur.pm * tstepA; const char* cB = (const char*)g.Bt + (size_t)cur.pn * tstepB;
    S.a_ready(cur);
    if constexpr (SP2) {
        PG8_STAGE(PG8_SB(0, 0), cB, voffB); PG8_STAGE(PG8_SB(0, 1), cB + hstepB, voffB); PG8_STAGE(PG8_SA(0, 0), cA, voffA); PG8_STAGE(PG8_SA(0, 1), cA + hstepA, voffA);
        if (wr == 1) PG8_BAR;
        PG8_WAIT_V(2); PG8_BAR;
        PG8_STAGE(PG8_SB(1, 0), cB + kstep, voffB); PG8_STAGE(PG8_SA(1, 0), cA + kstep, voffA); PG8_STAGE(PG8_SB(1, 1), cB + hstepB + kstep, voffB);
        PG8_WAIT_V(6); PG8_BAR;
    } else {
        PG8_STAGE(PG8_SB(0, 0), cB, voffB); PG8_STAGE(PG8_SA(0, 0), cA, voffA); PG8_STAGE(PG8_SB(0, 1), cB + hstepB, voffB); PG8_STAGE(PG8_SA(0, 1), cA + hstepA, voffA);
        if (wr == 1) PG8_BAR;
        PG8_WAIT_V(4); PG8_BAR;
        PG8_STAGE(PG8_SB(1, 0), cB + kstep, voffB); PG8_STAGE(PG8_SA(1, 0), cA + kstep, voffA); PG8_STAGE(PG8_SB(1, 1), cB + hstepB + kstep, voffB);
        PG8_WAIT_V(6); PG8_BAR;
    }
    for (;;) {
        const bool has_next = S.next(ui + 1, nxt);
        const char* nA = has_next ? (const char*)g.A + (size_t)nxt.pm * tstepA : cA; const char* nB = has_next ? (const char*)g.Bt + (size_t)nxt.pn * tstepB : cB;
        for (int t = 0; t < nt; t += 2) {
            const bool last = (t == nt - 2);
            const char* a1 = cA + (size_t)(t + 1) * kstep;
            const char* a2 = last ? nA : cA + (size_t)(t + 2) * kstep; const char* b2 = last ? nB : cB + (size_t)(t + 2) * kstep;
            const char* a3 = a2 + kstep; const char* b3 = b2 + kstep;
            if (last && has_next) S.a_ready(nxt);
            if constexpr (SP2) {
            PG8_LDB(B0, 0, 0); PG8_LDB(B1, 0, 1); PG8_SCHED; PG8_LDA(At, 0, 0); PG8_STAGE(PG8_SA(1, 1), a1 + hstepA, voffA);
            PG8_WAIT_V(8); PG8_WAIT_L(0); PG8_BAR; PG8_MMA(0, 0, At, B0); PG8_MMA(0, 1, At, B1); PG8_BAR; PG8_SCHED;
            PG8_LDA(At, 0, 1); PG8_STAGE(PG8_SB(0, 0), b2, voffB); PG8_STAGE(PG8_SB(0, 1), b2 + hstepB, voffB); PG8_STAGE(PG8_SA(0, 0), a2, voffA);
            PG8_WAIT_V(8); PG8_WAIT_L(0); PG8_BAR; PG8_MMA(1, 0, At, B0); PG8_MMA(1, 1, At, B1); PG8_BAR; PG8_SCHED;
            PG8_LDB(B0, 1, 0); PG8_LDB(B1, 1, 1); PG8_SCHED; PG8_LDA(At, 1, 0); PG8_STAGE(PG8_SA(0, 1), a2 + hstepA, voffA);
            PG8_WAIT_V(8); PG8_WAIT_L(0); PG8_BAR; PG8_MMA(0, 0, At, B0); PG8_MMA(0, 1, At, B1); PG8_BAR; PG8_SCHED;
            PG8_LDA(At, 1, 1); PG8_STAGE(PG8_SB(1, 0), b3, voffB); PG8_STAGE(PG8_SB(1, 1), b3 + hstepB, voffB); PG8_STAGE(PG8_SA(1, 0), a3, voffA);
            PG8_WAIT_V(8); PG8_WAIT_L(0); PG8_BAR; PG8_MMA(1, 0, At, B0); PG8_MMA(1, 1, At, B1); PG8_BAR; PG8_SCHED;
            } else {
            PG8_LDB(B0, 0, 0); PG8_SCHED; PG8_LDA(At, 0, 0); PG8_STAGE(PG8_SA(1, 1), a1 + hstepA, voffA);
            PG8_WAIT_L(8); PG8_BAR; PG8_WAIT_L(0); PG8_MMA(0, 0, At, B0); PG8_BAR; PG8_SCHED;
            PG8_LDB(B1, 0, 1); PG8_STAGE(PG8_SB(0, 0), b2, voffB);
            PG8_BAR; PG8_WAIT_L(0); PG8_MMA(0, 1, At, B1); PG8_BAR;
            PG8_LDA(At, 0, 1); PG8_STAGE(PG8_SA(0, 0), a2, voffA);
            PG8_BAR; PG8_WAIT_L(0); PG8_MMA(1, 0, At, B0); PG8_BAR; PG8_SCHED;
            PG8_STAGE(PG8_SB(0, 1), b2 + hstepB, voffB);
            PG8_WAIT_V(6); PG8_BAR; PG8_MMA(1, 1, At, B1); PG8_BAR;
            PG8_LDB(B0, 1, 0); PG8_SCHED; PG8_LDA(At, 1, 0); PG8_STAGE(PG8_SA(0, 1), a2 + hstepA, voffA);
            PG8_WAIT_L(8); PG8_BAR; PG8_WAIT_L(0); PG8_MMA(0, 0, At, B0); PG8_BAR; PG8_SCHED;
            PG8_LDB(B1, 1, 1); PG8_STAGE(PG8_SB(1, 0), b3, voffB);
            PG8_BAR; PG8_WAIT_L(0); PG8_MMA(0, 1, At, B1); PG8_BAR;
            PG8_LDA(At, 1, 1); PG8_STAGE(PG8_SA(1, 0), a3, voffA);
            PG8_BAR; PG8_WAIT_L(0); PG8_MMA(1, 0, At, B0); PG8_BAR; PG8_SCHED;
            PG8_STAGE(PG8_SB(1, 1), b3 + hstepB, voffB);
            PG8_WAIT_V(6); PG8_BAR; PG8_MMA(1, 1, At, B1); PG8_BAR;
            }
        }
        if constexpr (ALIGN_EPI) { if (wr == 0) PG8_BAR; }
        E(acc, cur, wr, wc, fr, fq); S.done(cur);
        if (!has_next) break;
#pragma unroll
        for (int a = 0; a < 2; ++a)
#pragma unroll
            for (int b = 0; b < 2; ++b)
#pragma unroll
                for (int m = 0; m < 4; ++m)
#pragma unroll
                    for (int n = 0; n < 2; ++n) acc[a][b][m][n] = (f32x4){0.f, 0.f, 0.f, 0.f};
        cur = nxt; cA = nA; cB = nB; ++ui;
        if constexpr (ALIGN_EPI) { if (wr == 1) PG8_BAR; }
    }
    PG8_WAIT_V(0);
    if constexpr (!ALIGN_EPI) { if (wr == 0) PG8_BAR; }
    PG8_BAR;
#undef PG8_SA
#undef PG8_SB
#undef PG8_STAGE
#undef PG8_LDA
#undef PG8_LDB
#undef PG8_MMA
#undef PG8_WAIT_V
#undef PG8_WAIT_L
#undef PG8_BAR
#undef PG8_SCHED
}
}

template <int ACT> __device__ __forceinline__ float actf(float v) { if (ACT == 1) return gelu_f(v); if (ACT == 2) return silu_f(v); if (ACT == 3) return v * C_QSCALE; return v; }
struct FEpiWin {
    static constexpr bool PERM = true, AFTER_DRAIN = false;
    bf16* z; bf16* kr; float* rsq; const float* rope;
    template <int ACT, bool SQ>
    __device__ __forceinline__ void tile(const f32x4 (&acc)[2][2][4][2], int row0, int col0, float* sqp, int fq) const {
#pragma unroll
        for (int ai = 0; ai < 2; ++ai)
#pragma unroll
            for (int m = 0; m < 4; ++m) { const int row = row0 + ai * 128 + m * 16; bf16* rowp = z + (size_t)row * ZW + col0; float s = 0.f;
#pragma unroll
                for (int bj = 0; bj < 2; ++bj) { f32x4 v0 = acc[ai][bj][m][0], v1 = acc[ai][bj][m][1];
#pragma unroll
                    for (int e = 0; e < 4; ++e) { v0[e] = actf<ACT>(v0[e]); v1[e] = actf<ACT>(v1[e]); }
                    if (SQ) s += (v0[0] * v0[0] + v0[1] * v0[1]) + (v0[2] * v0[2] + v0[3] * v0[3]) + (v1[0] * v1[0] + v1[1] * v1[1]) + (v1[2] * v1[2] + v1[3] * v1[3]);
                    v4u w; w.x = pg8::cvt_pk_bf16(v0[0], v0[1]); w.y = pg8::cvt_pk_bf16(v0[2], v0[3]); w.z = pg8::cvt_pk_bf16(v1[0], v1[1]); w.w = pg8::cvt_pk_bf16(v1[2], v1[3]);
                    *(GAS v4u*)(rowp + bj * 128) = w; }
                if (SQ) { s += swz_xor<16>(s); s = sum32(s); if (fq == 0) sqp[row] = s; } }
    }
    __device__ __forceinline__ void operator()(const f32x4 (&acc)[2][2][4][2], const pg8::Unit& u, int wr, int wc, int fr, int fq) const {
        const int row0 = u.pm * 256 + wr * 64 + fr, pn = u.pn;
        if (pn < 22) {
            const int col0 = pn * 256 + wc * 32 + 8 * fq; const int slot = (pn & 1) * 4 + wc;
            if (pn < 2) tile<1, false>(acc, row0, col0, nullptr, fq);
            else if (pn < 4) tile<1, true>(acc, row0, col0, rsq + (size_t)(0 * 8 + slot) * MR, fq);
            else if (pn < 6) tile<2, false>(acc, row0, col0, nullptr, fq);
            else if (pn < 8) tile<0, true>(acc, row0, col0, rsq + (size_t)(1 * 8 + slot) * MR, fq);
            else if (pn < 10) tile<0, true>(acc, row0, col0, rsq + (size_t)(2 * 8 + slot) * MR, fq);
            else if (pn < 14) tile<2, false>(acc, row0, col0, nullptr, fq);
            else if (pn < 16) tile<3, false>(acc, row0, col0, nullptr, fq);
            else if (pn < 20) tile<0, false>(acc, row0, col0, nullptr, fq);
            else tile<2, false>(acc, row0, col0, nullptr, fq);
        } else if (wc < 2) {
#pragma unroll
            for (int ai = 0; ai < 2; ++ai)
#pragma unroll
                for (int m = 0; m < 4; ++m) { const int row = row0 + ai * 128 + m * 16; const int b = row_b(row), t = row - b * TROWS; f32x4 x1 = acc[ai][0][m][0], x2 = acc[ai][0][m][1];
                    if (t < SEQ) { const int pos = wc == 0 ? (t >> 6) : (t & 63); const f32x4 cs = *(const GAS f32x4*)(rope + pos * 16 + 4 * fq), sn = *(const GAS f32x4*)(rope + 1024 + pos * 16 + 4 * fq);
                        const f32x4 a = x1 * cs - x2 * sn, bb = x2 * cs + x1 * sn; x1 = a; x2 = bb; }
                    v4u w; w.x = pg8::cvt_pk_bf16(x1[0], x1[1]); w.y = pg8::cvt_pk_bf16(x1[2], x1[3]); w.z = pg8::cvt_pk_bf16(x2[0], x2[1]); w.w = pg8::cvt_pk_bf16(x2[2], x2[3]);
                    *(GAS v4u*)(kr + (size_t)row * KRW + wc * 32 + 8 * fq) = w; }
        }
    }
};
struct FEpiKV {
    static constexpr bool PERM = true, AFTER_DRAIN = false;
    bf16* kv; const float* rsq;
    __device__ __forceinline__ void operator()(const f32x4 (&acc)[2][2][4][2], const pg8::Unit& u, int wr, int wc, int fr, int fq) const {
        const int row0 = u.pm * 256 + wr * 64 + fr, col0 = u.pn * 256 + wc * 32 + 8 * fq;
#pragma unroll
        for (int ai = 0; ai < 2; ++ai)
#pragma unroll
            for (int m = 0; m < 4; ++m) { const int row = row0 + ai * 128 + m * 16; const float rs = rstd512(rsq, 2, row);
#pragma unroll
                for (int bj = 0; bj < 2; ++bj) { const f32x4 v0 = acc[ai][bj][m][0] * rs, v1 = acc[ai][bj][m][1] * rs;
                    v4u w; w.x = pg8::cvt_pk_bf16(v0[0], v0[1]); w.y = pg8::cvt_pk_bf16(v0[2], v0[3]); w.z = pg8::cvt_pk_bf16(v1[0], v1[1]); w.w = pg8::cvt_pk_bf16(v1[2], v1[3]);
                    *(GAS v4u*)(kv + (size_t)row * KVW + col0 + bj * 128) = w; } }
    }
};
struct FEpiQ {
    static constexpr bool PERM = true, AFTER_DRAIN = false;
    bf16* q; const float* rsq; const float* rope;
    __device__ __forceinline__ void operator()(const f32x4 (&acc)[2][2][4][2], const pg8::Unit& u, int wr, int wc, int fr, int fq) const {
        const int row0 = u.pm * 256 + wr * 64 + fr;
#pragma unroll
        for (int ai = 0; ai < 2; ++ai)
#pragma unroll
            for (int m = 0; m < 4; ++m) { const int row = row0 + ai * 128 + m * 16; const int b = row_b(row), t = row - b * TROWS; const float rs = rstd512(rsq, 1, row);
#pragma unroll
                for (int bj = 0; bj < 2; ++bj) { const int c32 = u.pn * 256 + bj * 128 + wc * 32; const int d0 = c32 % 192;
                    f32x4 x1 = acc[ai][bj][m][0] * rs, x2 = acc[ai][bj][m][1] * rs;
                    if (d0 >= 128 && t < SEQ) { const int pos = d0 == 128 ? (t >> 6) : (t & 63); const f32x4 cs = *(const GAS f32x4*)(rope + pos * 16 + 4 * fq), sn = *(const GAS f32x4*)(rope + 1024 + pos * 16 + 4 * fq);
                        const f32x4 a = x1 * cs - x2 * sn, bb = x2 * cs + x1 * sn; x1 = a; x2 = bb; }
                    x1 = x1 * MLA_QSCALE; x2 = x2 * MLA_QSCALE;
                    v4u w; w.x = pg8::cvt_pk_bf16(x1[0], x1[1]); w.y = pg8::cvt_pk_bf16(x1[2], x1[3]); w.z = pg8::cvt_pk_bf16(x2[0], x2[1]); w.w = pg8::cvt_pk_bf16(x2[2], x2[3]);
                    *(GAS v4u*)(q + (size_t)row * QW + c32 + 8 * fq) = w; } }
    }
};
struct FEpiOut {
    static constexpr bool PERM = false, AFTER_DRAIN = false;
    const float* base; float* out; const float* basec; float* outc; const float* mod; int l;
    __device__ __forceinline__ void operator()(const f32x4 (&acc)[2][2][4][2], const pg8::Unit& u, int wr, int wc, int fr, int fq) const {
        const int row0 = u.pm * 256 + wr * 64 + fr, col0 = u.pn * 256 + wc * 32 + 4 * fq;
        const int b = u.pm >= 17 ? 1 : 0; const bool isc = (u.pm == 16 || u.pm == 33);
        const float* gate = mod + (size_t)(isc ? 2 : b) * 6144 + 2 * D;
        f32x4 gv[2][2];
#pragma unroll
        for (int bj = 0; bj < 2; ++bj)
#pragma unroll
            for (int n = 0; n < 2; ++n) gv[bj][n] = *(const GAS f32x4*)(gate + col0 + bj * 128 + n * 16);
#pragma unroll
        for (int ai = 0; ai < 2; ++ai)
#pragma unroll
            for (int m = 0; m < 4; ++m) { const int row = row0 + ai * 128 + m * 16; const int t = row - b * TROWS;
                const size_t o = isc ? ((size_t)b * CTX + (t - SEQ)) * D : ((size_t)b * SEQ + t) * D; const float* bp = (isc ? basec : base) + o + col0; float* op = (isc ? outc : out) + o + col0;
#pragma unroll
                for (int bj = 0; bj < 2; ++bj)
#pragma unroll
                    for (int n = 0; n < 2; ++n) { const f32x4 bs = *(const GAS f32x4*)(bp + bj * 128 + n * 16); *(GAS f32x4*)(op + bj * 128 + n * 16) = bs + gv[bj][n] * acc[ai][bj][m][n]; } }
    }
};


namespace att {
using bf16x8 = __attribute__((ext_vector_type(8))) short;
using s16x4  = __attribute__((ext_vector_type(4))) short;
using f32x16 = __attribute__((ext_vector_type(16))) float;
using u32x4  = __attribute__((ext_vector_type(4))) unsigned;
constexpr int NW = 8, QBLK = 32, KVBLK = 64;
constexpr int SHM_V = 16384, SHM_KN = 16384, SHM_KR = 8192;
constexpr int OFF_V = 0, OFF_KN = 2 * SHM_V, OFF_KR = OFF_KN + 2 * SHM_KN, OFF_WS = 131072, SHM_ATTN = OFF_WS + NW * 64 * 4;
constexpr float THR = 6.f;
#define AT_KSWZ(row, colB) ((row) * 256 + ((colB) ^ (((row) & 15) << 4)))
#define AT_KRSWZ(row, colB) ((row) * 128 + ((colB) ^ ((((row) >> 1) & 7) << 4)))
#define AT_SBAR() __builtin_amdgcn_sched_barrier(0)
__device__ __forceinline__ int crow(int r, int hi) { return (r & 3) + 8 * (r >> 2) + 4 * hi; }
__device__ __forceinline__ unsigned cvtpk(float lo, float hi) { unsigned r; asm volatile("v_cvt_pk_bf16_f32 %0, %1, %2" : "=v"(r) : "v"(lo), "v"(hi)); return r; }
__device__ __forceinline__ bf16x8 ld8(const bf16* p) { return *reinterpret_cast<const bf16x8*>(p); }

__device__ __forceinline__ void partialSM(f32x16& p0, f32x16& p1, float& m_reg, float& mn, float& alpha) {
  float pmax = p0[0];
#pragma unroll
  for (int r = 1; r < 16; ++r) pmax = fmaxf(pmax, p0[r]);
#pragma unroll
  for (int r = 0; r < 16; ++r) pmax = fmaxf(pmax, p1[r]);
  { auto rr = __builtin_amdgcn_permlane32_swap(__float_as_uint(pmax), __float_as_uint(pmax), false, false);
    pmax = fmaxf(__uint_as_float(rr[0]), __uint_as_float(rr[1])); }
  if (__builtin_expect(__all(pmax - m_reg <= THR), 1)) { mn = m_reg; alpha = 1.f; }
  else { mn = fmaxf(m_reg, pmax); alpha = __builtin_amdgcn_exp2f(m_reg - mn); m_reg = mn; }
#pragma unroll
  for (int r = 0; r < 16; ++r) p0[r] = p0[r] - mn;
#pragma unroll
  for (int r = 0; r < 16; ++r) p1[r] = p1[r] - mn;
#pragma unroll
  for (int r = 0; r < 16; ++r) p0[r] = __builtin_amdgcn_exp2f(p0[r]);
}
__device__ __forceinline__ void finishSM(f32x16& p0, f32x16& p1, float alpha, float& l_reg, bf16x8& pa0, bf16x8& pa1, bf16x8& pa2, bf16x8& pa3) {
#pragma unroll
  for (int r = 0; r < 16; ++r) p1[r] = __builtin_amdgcn_exp2f(p1[r]);
  float ps = 0;
#pragma unroll
  for (int r = 0; r < 16; ++r) ps += p0[r];
#pragma unroll
  for (int r = 0; r < 16; ++r) ps += p1[r];
  { auto rr = __builtin_amdgcn_permlane32_swap(__float_as_uint(ps), __float_as_uint(ps), false, false);
    ps = __uint_as_float(rr[0]) + __uint_as_float(rr[1]); }
  l_reg = l_reg * alpha + ps;
#define AT_PK4(P, BASE, OUT) do { unsigned a0 = cvtpk(P[BASE + 0], P[BASE + 1]), a1 = cvtpk(P[BASE + 2], P[BASE + 3]);   \
    unsigned b0 = cvtpk(P[BASE + 4], P[BASE + 5]), b1 = cvtpk(P[BASE + 6], P[BASE + 7]);                              \
    auto r0 = __builtin_amdgcn_permlane32_swap(a0, b0, false, false); auto r1 = __builtin_amdgcn_permlane32_swap(a1, b1, false, false); \
    u32x4 w = {r0[0], r1[0], r0[1], r1[1]}; OUT = *reinterpret_cast<bf16x8*>(&w); } while (0)
  AT_PK4(p0, 0, pa0); AT_PK4(p0, 8, pa1); AT_PK4(p1, 0, pa2); AT_PK4(p1, 8, pa3);
#undef AT_PK4
}
template <bool HASR>
__device__ __forceinline__ void qkt(f32x16& p0, f32x16& p1, const char* Kn, const char* Kr, const bf16x8* qr, int r32, int hi) {
  p0 = f32x16{}; p1 = f32x16{};
#pragma unroll
  for (int d0 = 0; d0 < 8; ++d0) { const int cb = (d0 * 16 + hi * 8) * 2;
    const bf16x8 b0 = *reinterpret_cast<const bf16x8*>(Kn + AT_KSWZ(r32, cb));
    const bf16x8 b1 = *reinterpret_cast<const bf16x8*>(Kn + AT_KSWZ(32 + r32, cb));
    p0 = __builtin_amdgcn_mfma_f32_32x32x16_bf16(b0, qr[d0], p0, 0, 0, 0);
    p1 = __builtin_amdgcn_mfma_f32_32x32x16_bf16(b1, qr[d0], p1, 0, 0, 0); }
  if constexpr (HASR) {
#pragma unroll
    for (int d0 = 0; d0 < 4; ++d0) { const int cb = (d0 * 16 + hi * 8) * 2;
      const bf16x8 b0 = *reinterpret_cast<const bf16x8*>(Kr + AT_KRSWZ(r32, cb));
      const bf16x8 b1 = *reinterpret_cast<const bf16x8*>(Kr + AT_KRSWZ(32 + r32, cb));
      p0 = __builtin_amdgcn_mfma_f32_32x32x16_bf16(b0, qr[8 + d0], p0, 0, 0, 0);
      p1 = __builtin_amdgcn_mfma_f32_32x32x16_bf16(b1, qr[8 + d0], p1, 0, 0, 0); }
  }
}
__device__ __forceinline__ int v_st(int k, int c) { const int kk = (k & ~0xC) | ((k & 4) << 1) | ((k & 8) >> 1); return ((kk >> 3) * 4 + (c >> 5)) * 512 + ((kk & 7) * 32 + (c & 31)) * 2; }
__device__ __forceinline__ int v_rd_base(int lane) { return ((lane & 3) << 3) | (((lane >> 2) & 3) << 6) | (((lane >> 4) & 1) << 5) | (((lane >> 5) & 1) << 8); }
constexpr int v_rd_off(int d0, int ks, int half) { return d0 * 512 + ks * 4096 + half * 2048; }
template <int OFF> __device__ __forceinline__ s16x4 tr_read(int vb) {
  s16x4 r; asm volatile("ds_read_b64_tr_b16 %0, %1 offset:%2" : "=&v"(r) : "v"(vb), "i"(OFF) : "memory"); return r;
}
template <int D0> __device__ __forceinline__ void pv_one(f32x16& od, int vb, bf16x8 pa0, bf16x8 pa1, bf16x8 pa2, bf16x8 pa3) {
  const s16x4 l0 = tr_read<v_rd_off(D0, 0, 0)>(vb), h0 = tr_read<v_rd_off(D0, 0, 1)>(vb), l1 = tr_read<v_rd_off(D0, 1, 0)>(vb), h1 = tr_read<v_rd_off(D0, 1, 1)>(vb);
  const s16x4 l2 = tr_read<v_rd_off(D0, 2, 0)>(vb), h2 = tr_read<v_rd_off(D0, 2, 1)>(vb), l3 = tr_read<v_rd_off(D0, 3, 0)>(vb), h3 = tr_read<v_rd_off(D0, 3, 1)>(vb);
  asm volatile("s_waitcnt lgkmcnt(0)" ::: "memory"); AT_SBAR();
#define AT_PK(L, H) (bf16x8){L[0], L[1], L[2], L[3], H[0], H[1], H[2], H[3]}
  od = __builtin_amdgcn_mfma_f32_32x32x16_bf16(pa0, AT_PK(l0, h0), od, 0, 0, 0);
  od = __builtin_amdgcn_mfma_f32_32x32x16_bf16(pa1, AT_PK(l1, h1), od, 0, 0, 0);
  od = __builtin_amdgcn_mfma_f32_32x32x16_bf16(pa2, AT_PK(l2, h2), od, 0, 0, 0);
  od = __builtin_amdgcn_mfma_f32_32x32x16_bf16(pa3, AT_PK(l3, h3), od, 0, 0, 0);
#undef AT_PK
}
__device__ __forceinline__ void pv_d0(f32x16* o, int vb, bf16x8 pa0, bf16x8 pa1, bf16x8 pa2, bf16x8 pa3) {
  pv_one<0>(o[0], vb, pa0, pa1, pa2, pa3); pv_one<1>(o[1], vb, pa0, pa1, pa2, pa3); pv_one<2>(o[2], vb, pa0, pa1, pa2, pa3); pv_one<3>(o[3], vb, pa0, pa1, pa2, pa3);
}
struct PlainTiles { __device__ __forceinline__ int row(int t) const { return t * KVBLK; } __device__ __forceinline__ void apply(f32x16&, f32x16&, int) const {} };
template <bool HASR, int ldq, int ldk, int ldr, int ldo, int ldg, class Hook>
__device__ __forceinline__ void attn_unit(const bf16* __restrict__ Qb, const bf16* __restrict__ Knb, const bf16* __restrict__ Vb, const bf16* __restrict__ Krb,
                                          int NT, bf16* __restrict__ Ob, const bf16* __restrict__ Gb, char* lds, int tid, const Hook& H) {
  constexpr int NQ = HASR ? 12 : 8;
  const int wid = tid >> 6, lane = tid & 63, r32 = lane & 31, hi = lane >> 5;
  char* V_lds = lds + OFF_V; char* KN_lds = lds + OFF_KN; char* KR_lds = lds + OFF_KR;
  float* ws = (float*)(lds + OFF_WS) + wid * 64; float* li_l = ws; float* al_l = ws + 32;
  float m_reg = -1e30f, l_reg = 0; f32x16 o[4] = {}; bf16x8 qr[NQ];
  const bf16* Qw = Qb + (size_t)(wid * QBLK + r32) * ldq + hi * 8;
#pragma unroll
  for (int d0 = 0; d0 < NQ; ++d0) qr[d0] = ld8(Qw + d0 * 16);
  const int sr = tid >> 4, sc = (tid & 15) * 8, vst0 = v_st(sr, sc), vst1 = v_st(32 + sr, sc);
  const int krow = tid >> 3, kcc = (tid & 7) * 8;
  const int vb0 = (int)(uintptr_t)V_lds + v_rd_base(lane);
  bf16x8 vs0, vs1, ks0, ks1, rs0;
#define AT_SLOAD(k0) do { vs0 = ld8(&Vb[(size_t)((k0) + sr) * ldk + sc]); vs1 = ld8(&Vb[(size_t)((k0) + 32 + sr) * ldk + sc]); \
    ks0 = ld8(&Knb[(size_t)((k0) + sr) * ldk + sc]); ks1 = ld8(&Knb[(size_t)((k0) + 32 + sr) * ldk + sc]); \
    if constexpr (HASR) rs0 = ld8(&Krb[(size_t)((k0) + krow) * ldr + kcc]); } while (0)
#define AT_SWRITE(b) do { *(bf16x8*)(V_lds + (b) * SHM_V + vst0) = vs0; *(bf16x8*)(V_lds + (b) * SHM_V + vst1) = vs1; const int kc = sc * 2; \
    *(bf16x8*)(KN_lds + (b) * SHM_KN + AT_KSWZ(sr, kc)) = ks0; *(bf16x8*)(KN_lds + (b) * SHM_KN + AT_KSWZ(32 + sr, kc)) = ks1; \
    if constexpr (HASR) *(bf16x8*)(KR_lds + (b) * SHM_KR + AT_KRSWZ(krow, kcc * 2)) = rs0; } while (0)
#define AT_RESC(a) do { if (__any((a) < 1.f)) { if (hi == 0) al_l[r32] = (a); asm volatile("s_waitcnt lgkmcnt(0)" ::: "memory"); \
    _Pragma("unroll") for (int d = 0; d < 4; ++d) _Pragma("unroll") for (int r = 0; r < 16; ++r) o[d][r] *= al_l[crow(r, hi)]; } } while (0)
  f32x16 pA0, pA1, pB0, pB1; float mnA, mnB, alA, alB; bf16x8 pa0, pa1, pa2, pa3;
  AT_SLOAD(H.row(0)); asm volatile("s_waitcnt vmcnt(0)" ::: "memory"); AT_SWRITE(0); __syncthreads();
  qkt<HASR>(pA0, pA1, KN_lds, KR_lds, qr, r32, hi); H.apply(pA0, pA1, 0); partialSM(pA0, pA1, m_reg, mnA, alA);
  AT_SLOAD(H.row(1));
  asm volatile("s_waitcnt vmcnt(0)" ::: "memory"); AT_SWRITE(1); __syncthreads();
  for (int j = 1; j + 1 < NT; j += 2) {
    AT_SBAR(); qkt<HASR>(pB0, pB1, KN_lds + SHM_KN, KR_lds + SHM_KR, qr, r32, hi); H.apply(pB0, pB1, j);
    finishSM(pA0, pA1, alA, l_reg, pa0, pa1, pa2, pa3); AT_SBAR();
    AT_SLOAD(H.row(j + 1)); AT_SBAR();
    pv_d0(o, vb0, pa0, pa1, pa2, pa3); partialSM(pB0, pB1, m_reg, mnB, alB);
    __syncthreads(); asm volatile("s_waitcnt vmcnt(0)" ::: "memory"); AT_SWRITE(0);
    AT_RESC(alB); __syncthreads();
    AT_SBAR(); qkt<HASR>(pA0, pA1, KN_lds, KR_lds, qr, r32, hi); H.apply(pA0, pA1, j + 1);
    finishSM(pB0, pB1, alB, l_reg, pa0, pa1, pa2, pa3); AT_SBAR();
    AT_SLOAD(H.row(j + 2)); AT_SBAR();
    pv_d0(o, vb0 + SHM_V, pa0, pa1, pa2, pa3); partialSM(pA0, pA1, m_reg, mnA, alA);
    __syncthreads(); asm volatile("s_waitcnt vmcnt(0)" ::: "memory"); AT_SWRITE(1);
    AT_RESC(alA); __syncthreads();
  }
  AT_SBAR(); qkt<HASR>(pB0, pB1, KN_lds + SHM_KN, KR_lds + SHM_KR, qr, r32, hi); H.apply(pB0, pB1, NT - 1);
  finishSM(pA0, pA1, alA, l_reg, pa0, pa1, pa2, pa3); AT_SBAR();
  pv_d0(o, vb0, pa0, pa1, pa2, pa3); partialSM(pB0, pB1, m_reg, mnB, alB);
  __syncthreads(); AT_RESC(alB);
  finishSM(pB0, pB1, alB, l_reg, pa0, pa1, pa2, pa3); AT_SBAR();
  pv_d0(o, vb0 + SHM_V, pa0, pa1, pa2, pa3);
  __syncthreads();
  if (hi == 0) li_l[r32] = l_reg;
  { float* stg = (float*)(lds + wid * 16384);
#pragma unroll
    for (int r = 0; r < 16; ++r) { const int orow = crow(r, hi);
#pragma unroll
      for (int d0 = 0; d0 < 4; ++d0) stg[orow * 128 + d0 * 32 + r32] = o[d0][r]; }
    asm volatile("s_waitcnt lgkmcnt(0)" ::: "memory");
    const int cc = (lane & 31) * 4;
#pragma unroll 4
    for (int it = 0; it < 16; ++it) { const int row = it * 2 + hi; const f32x4 v = *(const f32x4*)(stg + row * 128 + cc); const float rl = __builtin_amdgcn_rcpf(li_l[row]);
      const size_t grow = (size_t)(wid * QBLK + row);
      const v2u g = *(const GAS v2u*)(Gb + grow * ldg + cc);
      v2u w; w.x = cvtpk(v[0] * rl * bflo(g.x), v[1] * rl * bfhi(g.x)); w.y = cvtpk(v[2] * rl * bflo(g.y), v[3] * rl * bfhi(g.y));
      *(GAS v2u*)(Ob + grow * ldo + cc) = w; } }
  __syncthreads();
#undef AT_SLOAD
#undef AT_SWRITE
#undef AT_RESC
}
}


namespace att {
constexpr int OFF_TAB = OFF_WS + 2048;
struct NattenTiles {
    int rlo, nb, gr, r0w, qc, c0, hi; const LAS float* tab;
    __device__ __forceinline__ int row(int t) const { return t < 4 ? SEQ + 64 * t : 64 * (rlo + min(t - 4, nb - 1)); }
    __device__ __forceinline__ void apply(f32x16& p0, f32x16& p1, int t) const {
        if (t < 4) return;
        const int kr_ = rlo + (t - 4); const float NEGB = -1e30f;
        if (t - 4 >= nb || (unsigned)(kr_ - r0w) >= 8u) {
#pragma unroll
            for (int r = 0; r < 16; ++r) { p0[r] = NEGB; p1[r] = NEGB; }
            return; }
        const LAS float* tb = tab + (kr_ - gr + 7) * 32 + (15 - qc + 4 * hi);
        const int cb = 4 * hi - c0;
#pragma unroll
        for (int r = 0; r < 16; ++r) { const int kc = (r & 3) + 8 * (r >> 2);
            const float b0 = tb[kc], b1 = tb[kc + 32];
            p0[r] = (unsigned)(kc + cb) < 16u ? p0[r] + b0 : NEGB;
            p1[r] = (unsigned)(kc + 32 + cb) < 16u ? p1[r] + b1 : NEGB;
            if ((r & 3) == 3) __builtin_amdgcn_sched_barrier(0); }
    }
};
}
__device__ __forceinline__ void natten_fast_unit(Frame& F, int l, int n) {
    const int tid = fresh_tid(F.wave0); char* lds = (char*)F.lds;
    const int b = n >> 6, hh = (n >> 4) & 3, j = n & 15;
    LAS float* tab = (LAS float*)(F.lds + att::OFF_TAB);
    if (tid < 480) { const int dr = tid >> 5, dc = tid & 31; tab[tid] = dc < 31 ? F.rpb[((size_t)(l * 4 + hh) * 15 + dr) * 31 + dc] * LOG2E : 0.f; }
    const int wid = tid >> 6, lane = tid & 63;
    att::NattenTiles H; const int g0 = 4 * j, g3 = 4 * j + 3;
    H.rlo = min(max(g0 - 4, 0), 56); const int rhi = min(max(g3 - 4, 0), 56) + 7; H.nb = rhi - H.rlo + 1;
    H.gr = g0 + (wid >> 1); H.r0w = min(max(H.gr - 4, 0), 56); H.qc = (wid & 1) * 32 + (lane & 31); H.c0 = min(max(H.qc - 8, 0), 48); H.hi = lane >> 5; H.tab = tab;
    const int NT = 4 + H.nb + (H.nb & 1);
    const size_t kb = (size_t)b * TROWS, qb = kb + 256 * j;
    att::attn_unit<false, ZW, ZW, 1, D, ZW>(F.z + qb * ZW + Z_QC + hh * 128, F.z + kb * ZW + Z_KC + hh * 128, F.z + kb * ZW + Z_VC + hh * 128, nullptr,
                                            NT, F.mix + qb * D + 1536 + hh * 128, F.z + qb * ZW + Z_GC + hh * 128, lds, tid, H);
}
__device__ __forceinline__ void cctx_fast_unit(Frame& F, int n) {
    const int tid = fresh_tid(F.wave0); char* lds = (char*)F.lds;
    const int b = n >> 2, hh = n & 3; const size_t kb = (size_t)b * TROWS + SEQ;
    att::attn_unit<false, ZW, ZW, 1, D, ZW>(F.z + kb * ZW + Z_QC + hh * 128, F.z + kb * ZW + Z_KC + hh * 128, F.z + kb * ZW + Z_VC + hh * 128, nullptr,
                                            4, F.mix + kb * D + 1536 + hh * 128, F.z + kb * ZW + Z_GC + hh * 128, lds, tid, att::PlainTiles{});
}

__device__ __forceinline__ void gmlp_fast_unit(Frame& F, int l, int ch) {
    using namespace att;
    const int tid = fresh_tid(F.wave0); char* lds = (char*)F.lds;
    const int wid = tid >> 6, lane = tid & 63, r32 = lane & 31, hi = lane >> 5;
    const size_t R0 = (size_t)ch * 128;
#pragma unroll 4
    for (int i = 0; i < 16; ++i) { const int pc = i * 512 + tid; const int q = pc >> 6, c = (pc & 63) * 8;
        const float rs = rstd512(F.rowsq, 0, (int)R0 + q);
        const v4u w = *(const GAS v4u*)(F.z + (R0 + q) * ZW + Z_VA + c);
        v4u o; o.x = cvtpk(bflo(w.x) * rs, bfhi(w.x) * rs); o.y = cvtpk(bflo(w.y) * rs, bfhi(w.y) * rs); o.z = cvtpk(bflo(w.z) * rs, bfhi(w.z) * rs); o.w = cvtpk(bflo(w.w) * rs, bfhi(w.w) * rs);
        *(LAS v4u*)(F.lds + ((c >> 7) * 2 + (q >> 6)) * 16384 + v_st(q & 63, c & 127)) = o; }
    __syncthreads();
    const int g = wid >> 1; const int vb = (int)(uintptr_t)lds + g * 32768 + v_rd_base(lane);
    const bf16* Wg = F.wsb + (size_t)(l * 4 + g) * 128 * 128;
    f32x16 o[2][4] = {};
#pragma unroll
    for (int pi = 0; pi < 2; ++pi) { const int p = (2 * (wid & 1) + pi) * 32 + r32;
#pragma unroll
        for (int t = 0; t < 2; ++t) { const bf16* wp = Wg + (size_t)p * 128 + t * 64 + hi * 8;
            const bf16x8 pa0 = ld8(wp), pa1 = ld8(wp + 16), pa2 = ld8(wp + 32), pa3 = ld8(wp + 48);
            pv_d0(o[pi], vb + t * 16384, pa0, pa1, pa2, pa3); } }
    __syncthreads();
    LAS float* stg = (LAS float*)(F.lds + wid * 16384);
#pragma unroll
    for (int pi = 0; pi < 2; ++pi) { const int pb = 2 * (wid & 1) + pi;
#pragma unroll
        for (int r = 0; r < 16; ++r) { const int orow = crow(r, hi);
#pragma unroll
            for (int d0 = 0; d0 < 4; ++d0) stg[orow * 128 + d0 * 32 + r32] = o[pi][d0][r]; }
        asm volatile("s_waitcnt lgkmcnt(0)" ::: "memory");
        const int cc = (lane & 31) * 4; const int gc = g * 128 + cc;
        const f32x4 sg = *(const GAS f32x4*)(F.sgu_g + l * 512 + gc);
#pragma unroll 4
        for (int it = 0; it < 16; ++it) { const int row = it * 2 + hi; const int p = pb * 32 + row; const f32x4 v = *(const LAS f32x4*)(stg + row * 128 + cc);
            const float bs = F.b_s[(l * 4 + g) * 128 + p]; const size_t zr = (R0 + p) * ZW;
            const v2u uu = *(const GAS v2u*)(F.z + zr + Z_U + gc), ga = *(const GAS v2u*)(F.z + zr + Z_GA + gc);
            v2u w; w.x = cvtpk(bflo(uu.x) * (v[0] * sg[0] + bs) * bflo(ga.x), bfhi(uu.x) * (v[1] * sg[1] + bs) * bfhi(ga.x));
            w.y = cvtpk(bflo(uu.y) * (v[2] * sg[2] + bs) * bflo(ga.y), bfhi(uu.y) * (v[3] * sg[3] + bs) * bfhi(ga.y));
            *(GAS v2u*)(F.mix + (R0 + p) * D + gc) = w; }
        asm volatile("s_waitcnt lgkmcnt(0)" ::: "memory"); }
    __syncthreads();
}
__device__ __forceinline__ void sc_side_fast(Frame& F, int l) {
    PHASE_IDS(F);
    const int c = (int)blockIdx.x;
    if (c < 128) natten_fast_unit(F, l, c);
    const int nch = (l == 0) ? 68 : 64;
    for (int i = 255 - c; i < nch; i += 128) { int ch = i; if (l != 0) ch = i + (i >= 32 ? 2 : 0); gmlp_fast_unit(F, l, ch); }
    if (l == 0 && c >= 120 && c < 128) cctx_fast_unit(F, c - 120);
}

__device__ __forceinline__ void mla_fast(Frame& F, int l) {
    PHASE_IDS(F);
    char* lds = (char*)F.lds;
    const int nunits = 256 + (l == 0 ? 16 : 0);
    for (int u = F.vcu; u < nunits; u += F.G) {
        const int tid = fresh_tid(F.wave0);
        int b, hh, q0, k0, nk;
        if (u < 256) { const int bh = u >> 4; b = bh >> 3; hh = bh & 7; q0 = b * TROWS + (u & 15) * 256; k0 = b * TROWS; nk = TROWS; }
        else { const int bh = u - 256; b = bh >> 3; hh = bh & 7; q0 = b * TROWS + SEQ; k0 = q0; nk = CTX; }
        att::attn_unit<true, QW, KVW, KRW, D, ZW>(F.q + (size_t)q0 * QW + hh * 192, F.kv + (size_t)k0 * KVW + hh * 256, F.kv + (size_t)k0 * KVW + hh * 256 + 128, F.kr + (size_t)k0 * KRW,
                             nk / 64, F.mix + (size_t)q0 * D + 512 + hh * 128, F.z + (size_t)q0 * ZW + Z_GB + hh * 128, lds, tid, att::PlainTiles{});
    }
}

constexpr int NPHASES = 14;
__global__ void __launch_bounds__(NTHREADS, 2) mk_fwd(Args args) {
    extern __shared__ __attribute__((aligned(16))) unsigned char lds[];
    Frame F;
    F.lds = (LAS unsigned char*)lds; F.ws = args.ws;
    F.wave0 = __builtin_amdgcn_readfirstlane((int)threadIdx.x >> 6); PHASE_IDS(F);
    F.G = gridDim.x; { const int bx = blockIdx.x; F.vcu = (F.G % 8 == 0) ? (bx % 8) * (F.G / 8) + bx / 8 : bx; }
    F.x = args.in[0]; F.c = args.in[1]; F.ctx = args.in[2]; F.c_ctx = args.in[3]; F.w_ada = args.in[4]; F.b_ada = args.in[5]; F.norm_g = args.in[6]; F.w_in = args.in[7];
    F.qa_g = args.in[8]; F.kva_g = args.in[9]; F.w_uq = args.in[10]; F.w_ukv = args.in[11]; F.sgu_g = args.in[12]; F.w_s = args.in[13]; F.b_s = args.in[14]; F.rpb = args.in[15];
    F.w_out = args.in[16]; F.final_g = args.in[17]; F.out = args.out;
    unsigned char* ws = args.ws;
    F.mod = (float*)(ws + WS_MOD); F.rope = (float*)(ws + WS_ROPE); F.rowsq = (float*)(ws + WS_ROWSQ); F.xc = (float*)(ws + WS_XC);
    F.kr = (bf16*)(ws + WS_KR); F.wuq = (bf16*)(ws + WS_WUQ); F.wukv = (bf16*)(ws + WS_WUKV); F.wout = (bf16*)(ws + WS_WOUT); F.win = (bf16*)(ws + WS_WIN);
    F.h = (bf16*)(ws + WS_H); F.z = (bf16*)(ws + WS_Z); F.q = (bf16*)(ws + WS_Q); F.kv = (bf16*)(ws + WS_KV); F.mix = (bf16*)(ws + WS_MIX); F.wsb = (bf16*)(ws + WS_WSB);
    volatile LAS unsigned* MISC = (volatile LAS unsigned*)(F.lds + MISC_OFF);
    for (int u = F.tid; u < (LDS_BYTES - LDSCTL_OFF) / 4; u += NTHREADS) ((LAS unsigned*)(F.lds + LDSCTL_OFF))[u] = 0u;
    __syncthreads();
    XcdBarrier bar; bar.bar = (unsigned*)(ws + WS_CTL) + CW_BAR; bar.x = 0; bar.st = nullptr;
    if (MK_ONE_LAUNCH) bar = xcd_barrier_post((unsigned*)(ws + WS_CTL) + CW_BAR, MISC + 8, F.tid);
    const int lo = args.ph_lo, hi = args.ph_hi;
#define IN(k) (lo <= (k) && (k) < hi)
#define SEAM(k) do { if (IN(k) && IN((k) + 1)) xcd_barrier(bar, fresh_tid(F.wave0)); } while (0)
    if (IN(0)) { p0_prologue(F); } SEAM(0);
    for (int l = 0; l < DEPTH; ++l) {
        const int pb = 1 + 6 * l;
        if (IN(pb + 0)) { sa_phase(F, l); } SEAM(pb + 0);
#if FAST_GEMM
        if (IN(pb + 1)) { __syncthreads();
            pg8::Gemm g{F.h, F.win + (size_t)l * NIN_PAD * D, D, D}; pg8::TileOrder S; S.init(23, l == 0 ? 0x7FFFFFu : ((3u << 8) | (0xFu << 16) | (1u << 22)), F.G, (int)blockIdx.x);
            FEpiWin E{F.z, F.kr, F.rowsq, F.rope};
            pg8::gemm_phase<FEpiWin, pg8::TileOrder, true, true>(F.lds, g, S, E, fresh_tid(F.wave0)); } SEAM(pb + 1);
        SEAM(pb + 2);
        if (IN(pb + 3)) { __syncthreads();
            { pg8::Gemm g{F.z + Z_CKV, F.wukv + (size_t)l * KVW * 512, ZW, 512}; pg8::TileOrder S; S.init(8, 0xFFu, F.G, (int)blockIdx.x); FEpiKV E{F.kv, F.rowsq};
              pg8::gemm_phase<FEpiKV, pg8::TileOrder, true, true>(F.lds, g, S, E, fresh_tid(F.wave0)); }
            { pg8::Gemm g{F.z + Z_CQ, F.wuq + (size_t)l * QW * 512, ZW, 512}; pg8::TileOrder S; S.init(6, l == 0 ? 0x3Fu : 0u, F.G, F.G - 1 - (int)blockIdx.x); FEpiQ E{F.q, F.rowsq, F.rope};
              pg8::gemm_phase<FEpiQ, pg8::TileOrder, true, true>(F.lds, g, S, E, fresh_tid(F.wave0)); }
#if FAST_SIDE
            __syncthreads(); sc_side_fast(F, l);
#else
            __syncthreads(); gmlp_naive(F, l);
            __syncthreads(); natten_naive(F, l);
#endif
        } SEAM(pb + 3);
#else
        if (IN(pb + 1)) { __syncthreads(); naive_gemm(F, F.h, D, F.win + (size_t)l * NIN_PAD * D, MR, NIN, D, EpiWin{}); } SEAM(pb + 1);
        if (IN(pb + 2)) { rowsq_from_z(F); } SEAM(pb + 2);
        if (IN(pb + 3)) {
            __syncthreads(); naive_gemm(F, F.z + Z_CKV, ZW, F.wukv + (size_t)l * KVW * 512, MR, KVW, 512, EpiKV{});
            __syncthreads(); naive_gemm(F, F.z + Z_CQ, ZW, F.wuq + (size_t)l * QW * 512, MR, QW, 512, EpiQ{});
            __syncthreads(); gmlp_naive(F, l);
            __syncthreads(); natten_naive(F, l);
        } SEAM(pb + 3);
#endif
#if FAST_MLA
        if (IN(pb + 4)) { __syncthreads(); mla_fast(F, l); } SEAM(pb + 4);
#else
        if (IN(pb + 4)) { __syncthreads(); mla_naive(F, l); } SEAM(pb + 4);
#endif
#if FAST_GEMM
        if (IN(pb + 5)) { __syncthreads();
            pg8::Gemm g{F.mix, F.wout + (size_t)l * D * D, D, D}; pg8::TileOrder S; S.init(8, l == 0 ? 0xFFu : 0u, F.G, (int)blockIdx.x);
            FEpiOut E{l == 0 ? F.x : F.out, F.out, F.ctx, F.xc, F.mod + (size_t)l * 3 * 6144, l};
            pg8::gemm_phase<FEpiOut, pg8::TileOrder, true, true>(F.lds, g, S, E, fresh_tid(F.wave0)); } SEAM(pb + 5);
#else
        if (IN(pb + 5)) { __syncthreads(); naive_gemm(F, F.mix, D, F.wout + (size_t)l * D * D, MR, D, D, EpiOut{l}); } SEAM(pb + 5);
#endif
    }
    if (IN(13)) { final_phase(F); }
#undef IN
#undef SEAM
}

extern "C" void kernel_launch(void* const* d_in, const int* in_sizes, int n_in, void* d_out, int out_size, void* d_ws, size_t ws_size, hipStream_t stream) {
    static int grid = 0;
    if (grid == 0) {
        if (n_in != 18 || in_sizes[0] != NBATCH * SEQ * D || out_size != NBATCH * SEQ * D || ws_size < WS_END) {
            fprintf(stderr, "kernel_launch: unexpected shapes: n_in %d in0 %d out %d ws %zu (need %zu)\n", n_in, n_in > 0 ? in_sizes[0] : -1, out_size, ws_size, (size_t)WS_END); grid = -1; return; }
        int dev = 0, cus = 0;
        if (hipGetDevice(&dev) != hipSuccess || hipDeviceGetAttribute(&cus, hipDeviceAttributeMultiprocessorCount, dev) != hipSuccess) { grid = -1; return; }
        if (hipFuncSetAttribute((const void*)mk_fwd, hipFuncAttributeMaxDynamicSharedMemorySize, LDS_BYTES) != hipSuccess) { fprintf(stderr, "kernel_launch: hipFuncSetAttribute failed\n"); grid = -1; return; }
        int per_cu = 0;
        if (hipOccupancyMaxActiveBlocksPerMultiprocessor(&per_cu, (const void*)mk_fwd, NTHREADS, LDS_BYTES) != hipSuccess || per_cu < 1) fprintf(stderr, "kernel_launch: occupancy query says %d\n", per_cu);
        (void)hipGetLastError();
        grid = cus;
    }
    if (grid < 0) return;
    (void)hipMemsetAsync((char*)d_ws + WS_CTL, 0, CTL_ZERO_BYTES, stream);
    Args a{};
    for (int i = 0; i < 18; ++i) a.in[i] = (const float*)d_in[i];
    a.out = (float*)d_out; a.ws = (unsigned char*)d_ws;
#if MK_ONE_LAUNCH
    a.ph_lo = 0; a.ph_hi = NPHASES;
    hipLaunchKernelGGL(mk_fwd, dim3(grid), dim3(NTHREADS), LDS_BYTES, stream, a);
#else
    for (int p = 0; p < NPHASES; ++p) { a.ph_lo = p; a.ph_hi = p + 1; hipLaunchKernelGGL(mk_fwd, dim3(grid), dim3(NTHREADS), LDS_BYTES, stream, a); }
#endif
    const hipError_t le = hipPeekAtLastError();
    if (le != hipSuccess) fprintf(stderr, "kernel_launch: launch failed: %s\n", hipGetErrorName(le));
}
```

```cpp
#include <hip/hip_runtime.h>
#include <cstdio>
#include <cstdint>

#ifndef MK_ONE_LAUNCH
#define MK_ONE_LAUNCH 1
#endif
#ifndef FAST_MLA
#define FAST_MLA 1
#endif
#ifndef PROBE_REP
#define PROBE_REP -1
#endif
#ifndef FAST_SIDE
#define FAST_SIDE 1
#endif
#ifndef FAST_GEMM
#define FAST_GEMM 1
#endif

constexpr int D = 2048, NBATCH = 2, SEQ = 4096, CTX = 256, TROWS = SEQ + CTX  , MR = NBATCH * TROWS  ;
constexpr int DEPTH = 2, GRIDW = 64;
constexpr int INW = 5696;
constexpr int ZW = 5632;
constexpr int Z_U = 0, Z_VA = 512, Z_GA = 1024, Z_CQ = 1536, Z_CKV = 2048, Z_GB = 2560, Z_QC = 3584, Z_KC = 4096, Z_VC = 4608, Z_GC = 5120;
constexpr int NIN = 5696;
constexpr int QW = 1536, KVW = 2048, KRW = 64;
constexpr float EPS = 1e-6f;
constexpr float LOG2E = 1.4426950408889634f;
constexpr float MLA_QSCALE = 0.07216878364870322f * LOG2E;
constexpr float C_QSCALE = 0.08838834764831845f * LOG2E;

constexpr size_t MiB = 1u << 20;
constexpr size_t WS_CTL = 0, CTL_ZERO_BYTES = 1 * MiB;
constexpr size_t WS_MOD = 1 * MiB;
constexpr size_t WS_ROPE = WS_MOD + 256 * 1024;
constexpr size_t WS_WSB = 1536 * 1024;
constexpr size_t WS_ROWSQ = 7296 * 1024;
constexpr size_t WS_XC = 2 * MiB;
constexpr size_t WS_KR = 6 * MiB;
constexpr size_t WS_WUQ = 8 * MiB;
constexpr size_t WS_WUKV = 11 * MiB;
constexpr size_t WS_WOUT = 15 * MiB;
constexpr size_t WS_WIN = 31 * MiB;
constexpr size_t WS_H = 77 * MiB;
constexpr size_t WS_Z = 111 * MiB;
constexpr size_t WS_Q = 205 * MiB;
constexpr size_t WS_KV = 231 * MiB;
constexpr size_t WS_MIX = WS_H;
constexpr size_t WS_WFKR = 265 * MiB;
constexpr size_t WS_WFOUT = 266 * MiB;
constexpr size_t WS_END = 274 * MiB;
constexpr int NIN_PAD = 5888;

#define GAS __attribute__((address_space(1)))
#define LAS __attribute__((address_space(3)))
typedef unsigned short bf16;
typedef unsigned v4u __attribute__((ext_vector_type(4)));
typedef unsigned v2u __attribute__((ext_vector_type(2)));
typedef float f32x4 __attribute__((ext_vector_type(4)));
typedef GAS unsigned gu32;
#define RLX_AGENT __ATOMIC_RELAXED, __HIP_MEMORY_SCOPE_AGENT
#define LDS_WAIT() asm volatile("s_waitcnt lgkmcnt(0)" ::: "memory")
#define VM_WAIT() asm volatile("s_waitcnt vmcnt(0)" ::: "memory")
constexpr int NWAVES = 8, NTHREADS = 512;
__device__ __forceinline__ int fresh_tid(int wave0) { int l; asm volatile("v_mbcnt_lo_u32_b32 %0, -1, 0\n\tv_mbcnt_hi_u32_b32 %0, -1, %0" : "=v"(l)); return (wave0 << 6) | l; }
#define SUBREP(F, id) for (int sr_ = 0; sr_ < (PROBE_REP == (id) ? 2 : 1); ++sr_)
#define PHASE_IDS(F) do { (F).tid = fresh_tid((F).wave0); (F).lane = (F).tid & 63; (F).wave = (F).wave0; } while (0)

__device__ __forceinline__ unsigned f2bf(float f) { unsigned u = __builtin_bit_cast(unsigned, f); return (u + 0x7fffu + ((u >> 16) & 1u)) >> 16; }
__device__ __forceinline__ unsigned pk2(float lo, float hi) { return f2bf(lo) | (f2bf(hi) << 16); }
__device__ __forceinline__ float bf2f(unsigned short b) { return __builtin_bit_cast(float, (unsigned)b << 16); }
__device__ __forceinline__ float bflo(unsigned w) { return __builtin_bit_cast(float, w << 16); }
__device__ __forceinline__ float bfhi(unsigned w) { return __builtin_bit_cast(float, w & 0xffff0000u); }
__device__ __forceinline__ float fast_rcp(float x) { return __builtin_amdgcn_rcpf(x); }
__device__ __forceinline__ float silu_f(float x) { return x * fast_rcp(1.f + __builtin_amdgcn_exp2f(-LOG2E * x)); }
__device__ __forceinline__ float gelu_f(float x) { const float u = x + 0.044715f * x * x * x; return x * fast_rcp(1.f + __builtin_amdgcn_exp2f(-2.3022082f * u)); }
__device__ __forceinline__ float rstd512(const float* rsq, int j, int row) {
    float s = 0.f;
#pragma unroll
    for (int k = 0; k < 8; ++k) s += rsq[(size_t)(j * 8 + k) * MR + row];
    return 1.0f / sqrtf(s * (1.f / 512.f) + EPS);
}
template <int K> __device__ __forceinline__ float swz_xor(float v) { return __builtin_bit_cast(float, __builtin_amdgcn_ds_swizzle(__builtin_bit_cast(int, v), (K << 10) | 0x1F)); }
__device__ __forceinline__ float sum32(float v) { auto rr = __builtin_amdgcn_permlane32_swap(__float_as_uint(v), __float_as_uint(v), false, false); return __uint_as_float(rr[0]) + __uint_as_float(rr[1]); }
__device__ __forceinline__ float wave_sum(float v) {
    v += swz_xor<1>(v); v += swz_xor<2>(v); v += swz_xor<4>(v); v += swz_xor<8>(v); v += swz_xor<16>(v);
    { auto rr = __builtin_amdgcn_permlane32_swap(__float_as_uint(v), __float_as_uint(v), false, false); v = __uint_as_float(rr[0]) + __uint_as_float(rr[1]); }
    return v;
}
__device__ __forceinline__ float wave_max(float v) {
    v = fmaxf(v, swz_xor<1>(v)); v = fmaxf(v, swz_xor<2>(v)); v = fmaxf(v, swz_xor<4>(v)); v = fmaxf(v, swz_xor<8>(v)); v = fmaxf(v, swz_xor<16>(v));
    { auto rr = __builtin_amdgcn_permlane32_swap(__float_as_uint(v), __float_as_uint(v), false, false); v = fmaxf(__uint_as_float(rr[0]), __uint_as_float(rr[1])); }
    return v;
}

#define XB_TMO      128
#define XB_XCNT(j)  (256  + 64 * (j))
#define XB_XSUB(j)  (1280 + 64 * (j))
#define XB_XGEN(j)  (2304 + 64 * (j))
#define XB_TOP      3328
#define XB_TOPGEN   3392
#define XCD_BAR_WORDS 3456
#define XB_SPIN_CAP (1u << 23)
__device__ __forceinline__ unsigned xb_ld(unsigned* p)              { return __hip_atomic_load((GAS unsigned*)p, __ATOMIC_RELAXED, __HIP_MEMORY_SCOPE_AGENT); }
__device__ __forceinline__ unsigned xb_add(unsigned* p, unsigned v) { return __hip_atomic_fetch_add((GAS unsigned*)p, v, __ATOMIC_RELAXED, __HIP_MEMORY_SCOPE_AGENT); }
__device__ __forceinline__ unsigned xb_xcc_id() { return (unsigned)__builtin_amdgcn_s_getreg((3 << 11) | 20) & 0xFu; }
#define XB_SPIN(cond, bar) do { unsigned _sp = 0; while (cond) { __builtin_amdgcn_s_sleep(1); \
    if ((++_sp & 255u) == 0u) { if (xb_ld(&(bar)[XB_TMO])) break; if (_sp > XB_SPIN_CAP) { xb_add(&(bar)[XB_TMO], 1u); break; } } } } while (0)
struct XcdBarrier { unsigned* bar; unsigned x; volatile LAS unsigned* st; };
__device__ __forceinline__ XcdBarrier xcd_barrier_post(unsigned* bar, volatile LAS unsigned* st, int tid) {
    XcdBarrier b; b.bar = bar; b.x = xb_xcc_id(); b.st = st;
    if (tid == 0) (void)xb_add(&bar[XB_XCNT(b.x)], 1u);
    return b;
}
__device__ __forceinline__ void xcd_barrier_complete(unsigned* bar, unsigned x, unsigned& nloc, unsigned& nx) {
    const unsigned G = gridDim.x * gridDim.y * gridDim.z;
    unsigned sum, cnt, mine, sp = 0u;
    for (;;) {
        sum = 0u; cnt = 0u; mine = 0u;
#pragma unroll
        for (unsigned j = 0; j < 16; ++j) { const unsigned c = xb_ld(&bar[XB_XCNT(j)]); sum += c; cnt += (c > 0u) ? 1u : 0u; mine = (j == x) ? c : mine; }
        if (sum == G) break;
        __builtin_amdgcn_s_sleep(1);
        if ((++sp & 255u) == 0u) { if (xb_ld(&bar[XB_TMO])) break; if (sp > XB_SPIN_CAP) { xb_add(&bar[XB_TMO], 1u); break; } }
    }
    nloc = mine > 0u ? mine : 1u; nx = cnt > 0u ? cnt : 1u;
}
__device__ __forceinline__ void xcd_barrier(unsigned* bar_, volatile LAS unsigned* st_, int tid) {
    XcdBarrier b; b.bar = bar_; b.x = xb_xcc_id(); b.st = st_;
    asm volatile("s_waitcnt vmcnt(0)" ::: "memory");
    __syncthreads();
    if (tid == 0) {
        unsigned* bar = b.bar; asm volatile("" : "+s"(bar));
        __builtin_amdgcn_s_waitcnt(0);
        unsigned nloc = b.st[0], nx = b.st[1];
        if (nloc == 0u) { xcd_barrier_complete(bar, b.x, nloc, nx); b.st[0] = nloc; b.st[1] = nx; }
        const unsigned old = xb_add(&bar[XB_XSUB(b.x)], 1u);
        const unsigned gen = old / nloc;
        if (old + 1u == (gen + 1u) * nloc) {
            __builtin_amdgcn_fence(__ATOMIC_RELEASE, "agent");
            asm volatile("s_waitcnt vmcnt(0)" ::: "memory");
            const unsigned og = xb_add(&bar[XB_TOP], 1u);
            const unsigned tg = og / nx;
            if (og + 1u == (tg + 1u) * nx) xb_add(&bar[XB_TOPGEN], 1u);
            else XB_SPIN(xb_ld(&bar[XB_TOPGEN]) == tg, bar);
            __builtin_amdgcn_fence(__ATOMIC_ACQUIRE, "agent");
            xb_add(&bar[XB_XGEN(b.x)], 1u);
            asm volatile("s_waitcnt vmcnt(0)" ::: "memory");
        } else {
            XB_SPIN(xb_ld(&bar[XB_XGEN(b.x)]) == gen, bar);
            __builtin_amdgcn_fence(__ATOMIC_ACQUIRE, "agent");
            asm volatile("s_waitcnt vmcnt(0)" ::: "memory");
        }
    }
    __syncthreads();
}

constexpr int RING_BYTES = 147456;
constexpr int LDSCTL_OFF = RING_BYTES, MISC_OFF = LDSCTL_OFF + 320;
constexpr int LDS_BYTES = 151552;
constexpr int CW_BAR = 4096;

struct Args {
    const float* in[18]; float* out; unsigned char* ws; int ph_lo, ph_hi, probe, pad;
};
struct Frame {
    LAS unsigned char* lds; unsigned char* ws; int tid, lane, wave, wave0, vcu, G, probe;
    const float *x, *c, *ctx, *c_ctx, *w_ada, *b_ada, *norm_g, *w_in, *qa_g, *kva_g, *w_uq, *w_ukv, *sgu_g, *w_s, *b_s, *rpb, *w_out, *final_g;
    float* out;
    float *mod, *rope, *rowsq, *xc;
    bf16 *kr, *wuq, *wukv, *wout, *win, *h, *z, *q, *kv, *mix, *wsb, *wfkr, *wfout;
};

__device__ __forceinline__ int row_b(int R) { return R >= TROWS ? 1 : 0; }

__device__ __forceinline__ void p0_transpose_item(const float* W, int K, int Nsrc, int nsrc0, bf16* WT, int nrow0, const float* gk, LAS float* scr, int k0, int lane, bool ropeperm, bool fragmajor = false) {
#pragma unroll 8
    for (int i = 0; i < 32; ++i) { const int kk = 2 * i + (lane >> 5); float v = W[(size_t)(k0 + kk) * Nsrc + nsrc0 + (lane & 31)]; if (gk) v *= gk[k0 + kk]; scr[kk * 33 + (lane & 31)] = v; }
    LDS_WAIT(); asm volatile("" ::: "memory");
    const int c = lane & 7;
#pragma unroll
    for (int j = 0; j < 4; ++j) { const int n = (lane >> 3) + 8 * j; const LAS float* s = scr + (8 * c) * 33 + n;
        v4u o; o.x = pk2(s[0 * 33], s[1 * 33]); o.y = pk2(s[2 * 33], s[3 * 33]); o.z = pk2(s[4 * 33], s[5 * 33]); o.w = pk2(s[6 * 33], s[7 * 33]);
        const int nd = ropeperm ? (8 * ((n >> 2) & 3) + 4 * (n >> 4) + (n & 3)) : n;
        if (fragmajor) { const int kk = k0 + 8 * c; *(GAS v4u*)(WT + ((size_t)((nrow0 >> 5) * 128 + (kk >> 4)) * 512 + (((kk >> 3) & 1) * 32 + nd) * 8)) = o; }
        else *(GAS v4u*)(WT + (size_t)(nrow0 + nd) * K + k0 + 8 * c) = o; }
    LDS_WAIT(); asm volatile("" ::: "memory");
}
__device__ __forceinline__ void p0_prologue(Frame& F) {
    PHASE_IDS(F);
    LAS float* scr = (LAS float*)(F.lds + F.wave * 16384);
    const int gw = F.vcu * NWAVES + F.wave, NGW = F.G * NWAVES;
    constexpr int I_IN = (NIN / 32) * (D / 64), I_OUT = (D / 32) * (D / 64), I_UQ = (QW / 32) * (512 / 64), I_UKV = (KVW / 32) * (512 / 64), I_L = I_IN + I_OUT + I_UQ + I_UKV;
#if FAST_GEMM
    for (int it = gw; it < DEPTH * 64 + I_OUT; it += NGW) {
        if (it < DEPTH * 64) { const int l = it >> 6, nb = (it >> 5) & 1, kb = it & 31;
            p0_transpose_item(F.w_in + (size_t)l * D * INW, D, INW, 2560 + nb * 32, F.wfkr + (size_t)l * 2 * 128 * 512, nb * 32, nullptr, scr, kb * 64, F.lane, true, true); }
        else { const int r = it - DEPTH * 64, nb = r / (D / 64), kb = r % (D / 64);
            p0_transpose_item(F.w_out, D, D, nb * 32, F.wfout, nb * 32, nullptr, scr, kb * 64, F.lane, false, true); }
    }
#endif
    for (int it = gw; it < DEPTH * I_L; it += NGW) {
        const int l = it / I_L; int r = it % I_L;
        if (r < I_IN) { const int nb = r / (D / 64), kb = r % (D / 64); const int n0 = nb * 32; if (FAST_GEMM && n0 >= ZW) continue; const int ns = n0 < 5632 ? (n0 < 2560 ? n0 : n0 + 64) : (2560 + (n0 - 5632));
            p0_transpose_item(F.w_in + (size_t)l * D * INW, D, INW, ns, F.win + (size_t)l * NIN_PAD * D, n0, nullptr, scr, kb * 64, F.lane, FAST_GEMM && n0 >= 5632); continue; } r -= I_IN;
        if (r < I_OUT) { const int nb = r / (D / 64), kb = r % (D / 64);
            p0_transpose_item(F.w_out + (size_t)l * D * D, D, D, nb * 32, F.wout + (size_t)l * D * D, nb * 32, nullptr, scr, kb * 64, F.lane, false); continue; } r -= I_OUT;
        if (r < I_UQ) { const int nb = r / 8, kb = r % 8;
            p0_transpose_item(F.w_uq + (size_t)l * 512 * QW, 512, QW, nb * 32, F.wuq + (size_t)l * QW * 512, nb * 32, F.qa_g + l * 512, scr, kb * 64, F.lane, FAST_GEMM && ((nb * 32) % 192) >= 128); continue; } r -= I_UQ;
        { const int nb = r / 8, kb = r % 8;
            p0_transpose_item(F.w_ukv + (size_t)l * 512 * KVW, 512, KVW, nb * 32, F.wukv + (size_t)l * KVW * 512, nb * 32, F.kva_g + l * 512, scr, kb * 64, F.lane, false); }
    }
    { const size_t per = (size_t)(NIN_PAD - NIN) * D / 8;
      for (size_t i = (size_t)blockIdx.x * NTHREADS + F.tid; i < DEPTH * per; i += (size_t)F.G * NTHREADS) { const size_t l = i / per, j = i % per;
          *(GAS v4u*)(F.win + l * NIN_PAD * D + (size_t)NIN * D + j * 8) = (v4u){0u, 0u, 0u, 0u}; } }
    for (int i = blockIdx.x * NTHREADS + F.tid; i < DEPTH * 4 * 128 * 128 / 4; i += F.G * NTHREADS) { const f32x4 v = *(const GAS f32x4*)(F.w_s + 4 * (size_t)i);
        *(GAS v2u*)(F.wsb + 4 * (size_t)i) = (v2u){pk2(v.x, v.y), pk2(v.z, v.w)}; }
    for (int i = blockIdx.x * NTHREADS + F.tid; i < 1024; i += F.G * NTHREADS) { const int pos = i >> 4, fi = i & 15;
        const float inv = exp2f(-(float)fi * (13.287712379549449f / 16.f)); const float ang = (float)pos * inv;
        F.rope[i] = cosf(ang); F.rope[1024 + i] = sinf(ang); }
    __syncthreads();
    LAS float* sv = (LAS float*)F.lds;
    LAS float* red = (LAS float*)(F.lds + 32768);
    bool have_sv = false;
    SUBREP(F, 103) for (int u = F.vcu; u < DEPTH * 192; u += F.G) {
        if (!have_sv) { for (int i = F.tid; i < 3 * D; i += NTHREADS) { const int j = i / D, k = i % D; const float cv = j < 2 ? F.c[j * D + k] : F.c_ctx[k]; sv[i] = silu_f(cv); } have_sv = true; __syncthreads(); }
        const int l = u / 192, n0 = (u % 192) * 32, col = F.lane & 31, kh = F.lane >> 5;
        const float* wp = F.w_ada + (size_t)l * D * 6144 + n0 + col;
        float a0 = 0.f, a1 = 0.f, a2 = 0.f;
#pragma unroll 8
        for (int i = 0; i < 128; ++i) { const int k = F.wave * 256 + 2 * i + kh; const float w = wp[(size_t)k * 6144]; a0 += sv[k] * w; a1 += sv[D + k] * w; a2 += sv[2 * D + k] * w; }
        a0 = sum32(a0); a1 = sum32(a1); a2 = sum32(a2);
        if (F.lane < 32) { red[(F.wave * 3 + 0) * 32 + col] = a0; red[(F.wave * 3 + 1) * 32 + col] = a1; red[(F.wave * 3 + 2) * 32 + col] = a2; }
        __syncthreads();
        if (F.tid < 96) { const int j = F.tid / 32, cc = F.tid % 32; float s = 0.f;
#pragma unroll
            for (int w = 0; w < 8; ++w) s += red[(w * 3 + j) * 32 + cc];
            F.mod[(size_t)(l * 3 + j) * 6144 + n0 + cc] = s + F.b_ada[l * 6144 + n0 + cc]; }
        __syncthreads();
    }
}

constexpr int ALDS_PITCH = 4112;
typedef __attribute__((ext_vector_type(8))) short sk_bf16x8;
typedef __attribute__((ext_vector_type(16))) float sk_f32x16;
template <int NB, bool TWO>
__device__ __forceinline__ void skinny_lds(LAS unsigned char* lds, int nrows, const bf16* wf, sk_f32x16 (&acc0)[NB], sk_f32x16 (&acc1)[NB], int tid) {
    const int wid = tid >> 6, lane = tid & 63, r32 = lane & 31, hi = lane >> 5;
    const LAS unsigned char* ra0 = lds + r32 * ALDS_PITCH + hi * 16 + wid * 512;
    const LAS unsigned char* ra1 = lds + (32 + min(r32, max(nrows - 33, 0))) * ALDS_PITCH + hi * 16 + wid * 512;
    const bf16* bp = wf + (size_t)(wid * 16) * 512 + lane * 8;
#pragma unroll
    for (int hf = 0; hf < 2; ++hf) {
        sk_bf16x8 b[NB][8];
#pragma unroll
        for (int i = 0; i < 8; ++i)
#pragma unroll
            for (int nb = 0; nb < NB; ++nb) b[nb][i] = *(const GAS sk_bf16x8*)(bp + (size_t)(nb * 128 + hf * 8 + i) * 512);
#pragma unroll
        for (int i = 0; i < 8; ++i) { const sk_bf16x8 a0 = *(const LAS sk_bf16x8*)(ra0 + (hf * 8 + i) * 32); sk_bf16x8 a1; if (TWO) a1 = *(const LAS sk_bf16x8*)(ra1 + (hf * 8 + i) * 32);
#pragma unroll
            for (int nb = 0; nb < NB; ++nb) { acc0[nb] = __builtin_amdgcn_mfma_f32_32x32x16_bf16(a0, b[nb][i], acc0[nb], 0, 0, 0);
                if (TWO) acc1[nb] = __builtin_amdgcn_mfma_f32_32x32x16_bf16(a1, b[nb][i], acc1[nb], 0, 0, 0); } }
    }
}
__device__ __forceinline__ int sk_crow(int r, int hi) { return (r & 3) + 8 * (r >> 2) + 4 * hi; }
__device__ __forceinline__ float red_sum8(const LAS float* red, int stride8, int idx) {
    float s = 0.f;
#pragma unroll
    for (int w = 0; w < 8; ++w) s += red[w * stride8 + idx];
    return s;
}
__device__ __forceinline__ void rope_pair(const float* rope, int pos, int i, float& x1, float& x2);
__device__ __forceinline__ void sa_phase(Frame& F, int l) {
    PHASE_IDS(F);
    const float* xl = (l == 0) ? F.x : F.out;
    const float* xcl = (l == 0) ? F.ctx : F.xc;
    constexpr int RPC = 34;
    const int Rb0 = (int)blockIdx.x * RPC, nrows = min(RPC, MR - Rb0);
    auto rowsrc = [&](int R) -> const float* { const int b = row_b(R), t = R - b * TROWS; return t >= SEQ ? xcl + ((size_t)b * CTX + (t - SEQ)) * D : xl + ((size_t)b * SEQ + t) * D; };
    SUBREP(F, 101 + 10 * l) {
    f32x4 v[5][8];
#pragma unroll
    for (int m = 0; m < 5; ++m) { const int i = F.wave + 8 * m;
        if (i < nrows) { const GAS f32x4* xr = (const GAS f32x4*)rowsrc(Rb0 + i) + F.lane;
#pragma unroll
            for (int j = 0; j < 8; ++j) v[m][j] = xr[64 * j]; } }
#pragma unroll
    for (int m = 0; m < 5; ++m) { const int i = F.wave + 8 * m;
        if (i < nrows) {
            const int R = Rb0 + i; const int b = row_b(R), t = R - b * TROWS; const bool isc = t >= SEQ;
            const float* md = F.mod + (size_t)(l * 3 + (isc ? 2 : b)) * 6144;
            float s = 0.f;
#pragma unroll
            for (int j = 0; j < 8; ++j) s += (v[m][j].x * v[m][j].x + v[m][j].y * v[m][j].y) + (v[m][j].z * v[m][j].z + v[m][j].w * v[m][j].w);
            const float rstd = 1.0f / sqrtf(wave_sum(s) * (1.f / D) + EPS);
            GAS v2u* o8 = (GAS v2u*)(F.h + (size_t)R * D) + F.lane;
            LAS v2u* l8 = (LAS v2u*)(F.lds + i * ALDS_PITCH) + F.lane;
#pragma unroll
            for (int j = 0; j < 8; ++j) { const int c0 = 4 * F.lane + 256 * j;
                const f32x4 g = *(const GAS f32x4*)(F.norm_g + l * D + c0), sh = *(const GAS f32x4*)(md + c0), sc = *(const GAS f32x4*)(md + D + c0);
                const f32x4 y = v[m][j] * rstd * g * (sc + 1.0f) + sh;
                const v2u w = (v2u){pk2(y.x, y.y), pk2(y.z, y.w)};
                o8[64 * j] = w; l8[64 * j] = w; } } }
    }
#if FAST_GEMM
    __syncthreads();
    if (nrows > 0) SUBREP(F, 102 + 10 * l) {
        sk_f32x16 a0[2], a1[2];
#pragma unroll
        for (int nb = 0; nb < 2; ++nb) { a0[nb] = sk_f32x16{}; a1[nb] = sk_f32x16{}; }
        skinny_lds<2, true>(F.lds, nrows, F.wfkr + (size_t)l * 2 * 128 * 512, a0, a1, F.tid);
        __syncthreads();
        LAS float* red = (LAS float*)F.lds; const int r32 = F.lane & 31, hi = F.lane >> 5;
#pragma unroll
        for (int nb = 0; nb < 2; ++nb) {
#pragma unroll
            for (int r = 0; r < 16; ++r) red[(F.wave * RPC + sk_crow(r, hi)) * 64 + nb * 32 + r32] = a0[nb][r];
            if (hi == 0) { red[(F.wave * RPC + 32) * 64 + nb * 32 + r32] = a1[nb][0]; red[(F.wave * RPC + 33) * 64 + nb * 32 + r32] = a1[nb][1]; } }
        __syncthreads();
        for (int e = F.tid; e < RPC * 32; e += NTHREADS) { const int row = e >> 5, pr = e & 31, ax = pr >> 4, fi = pr & 15;
            if (row < nrows) { const int s1 = ax * 32 + 8 * (fi >> 2) + (fi & 3); const int R = Rb0 + row; const int b = row_b(R), t = R - b * TROWS;
                float x1 = red_sum8(red, RPC * 64, row * 64 + s1), x2 = red_sum8(red, RPC * 64, row * 64 + s1 + 4);
                if (t < SEQ) { const int pos = ax == 0 ? (t >> 6) : (t & 63); rope_pair(F.rope, pos, fi, x1, x2); }
                *(GAS bf16*)(F.kr + (size_t)R * KRW + s1) = (bf16)f2bf(x1); *(GAS bf16*)(F.kr + (size_t)R * KRW + s1 + 4) = (bf16)f2bf(x2); } }
        __syncthreads();
    }
#endif
}
__device__ __forceinline__ void final_phase(Frame& F) {
    PHASE_IDS(F);
    const int gw = F.vcu * NWAVES + F.wave, NGW = F.G * NWAVES;
    for (int R = gw; R < NBATCH * SEQ; R += NGW) {
        GAS f32x4* xr = (GAS f32x4*)(F.out + (size_t)R * D) + F.lane;
        f32x4 v[8]; float s = 0.f;
#pragma unroll
        for (int j = 0; j < 8; ++j) { v[j] = xr[64 * j]; s += (v[j].x * v[j].x + v[j].y * v[j].y) + (v[j].z * v[j].z + v[j].w * v[j].w); }
        const float rstd = 1.0f / sqrtf(wave_sum(s) * (1.f / D) + EPS);
#pragma unroll
        for (int j = 0; j < 8; ++j) { const f32x4 g = *(const GAS f32x4*)(F.final_g + 4 * F.lane + 256 * j); xr[64 * j] = v[j] * rstd * g; }
    }
}

template <class Epi>
__device__ __forceinline__ void naive_gemm(Frame& F, const bf16* A, int lda, const bf16* Bt, int M, int N, int K, const Epi& E) {
    PHASE_IDS(F);
    LAS float* As = (LAS float*)F.lds;
    LAS float* Bs = (LAS float*)(F.lds + 32 * 132 * 4);
    const int tid = F.tid, ty = tid >> 4, tx = tid & 15;
    const int nM = M / 128, nN = N / 64;
    for (int u = F.vcu; u < nM * nN; u += F.G) {
        const int pm = u / nN, pn = u % nN, r0 = pm * 128, n0 = pn * 64;
        float acc[4][4];
#pragma unroll
        for (int i = 0; i < 4; ++i)
#pragma unroll
            for (int j = 0; j < 4; ++j) acc[i][j] = 0.f;
        for (int k0 = 0; k0 < K; k0 += 32) {
            { const int row = tid >> 2, kc = (tid & 3) * 8; const v4u w = *(const GAS v4u*)(A + (size_t)(r0 + row) * lda + k0 + kc);
              As[(kc + 0) * 132 + row] = bflo(w.x); As[(kc + 1) * 132 + row] = bfhi(w.x); As[(kc + 2) * 132 + row] = bflo(w.y); As[(kc + 3) * 132 + row] = bfhi(w.y);
              As[(kc + 4) * 132 + row] = bflo(w.z); As[(kc + 5) * 132 + row] = bfhi(w.z); As[(kc + 6) * 132 + row] = bflo(w.w); As[(kc + 7) * 132 + row] = bfhi(w.w); }
            { const int row = tid >> 3, kc = (tid & 7) * 4; const v2u w = *(const GAS v2u*)(Bt + (size_t)(n0 + row) * K + k0 + kc);
              Bs[(kc + 0) * 68 + row] = bflo(w.x); Bs[(kc + 1) * 68 + row] = bfhi(w.x); Bs[(kc + 2) * 68 + row] = bflo(w.y); Bs[(kc + 3) * 68 + row] = bfhi(w.y); }
            __syncthreads();
#pragma unroll 8
            for (int k = 0; k < 32; ++k) {
                const f32x4 a = *(const LAS f32x4*)(As + k * 132 + 4 * ty);
                float bv[4];
#pragma unroll
                for (int j = 0; j < 4; ++j) bv[j] = Bs[k * 68 + tx + 16 * j];
#pragma unroll
                for (int j = 0; j < 4; ++j) { acc[0][j] += a.x * bv[j]; acc[1][j] += a.y * bv[j]; acc[2][j] += a.z * bv[j]; acc[3][j] += a.w * bv[j]; }
            }
            __syncthreads();
        }
#pragma unroll
        for (int i = 0; i < 4; ++i) { const int R = r0 + 4 * ty + i; E.pair(F, R, n0 + tx, acc[i][0], acc[i][1]); E.pair(F, R, n0 + 32 + tx, acc[i][2], acc[i][3]); }
    }
}
__device__ __forceinline__ void st_bf(bf16* p, float v) { *(GAS bf16*)p = (bf16)f2bf(v); }
__device__ __forceinline__ void rope_pair(const float* rope, int pos, int i, float& x1, float& x2) {
    const float cs = rope[pos * 16 + i], sn = rope[1024 + pos * 16 + i]; const float a = x1 * cs - x2 * sn, b = x2 * cs + x1 * sn; x1 = a; x2 = b;
}
struct EpiWin {
    __device__ __forceinline__ float act(int n, float v) const {
        if (n < Z_GA) return gelu_f(v);
        if (n < Z_CQ) return silu_f(v);
        if (n < Z_GB) return v;
        if (n < Z_QC) return silu_f(v);
        if (n < Z_KC) return v * C_QSCALE;
        if (n < Z_GC) return v;
        return silu_f(v);
    }
    __device__ __forceinline__ void pair(Frame& F, int R, int n, float v0, float v1) const {
        if (n < ZW) { st_bf(F.z + (size_t)R * ZW + n, act(n, v0)); st_bf(F.z + (size_t)R * ZW + n + 16, act(n + 16, v1)); }
        else { const int d = n - ZW; const int b = row_b(R), t = R - b * TROWS;
            if (t < SEQ) { const int pos = d < 32 ? (t >> 6) : (t & 63); rope_pair(F.rope, pos, d & 15, v0, v1); }
            st_bf(F.kr + (size_t)R * KRW + d, v0); st_bf(F.kr + (size_t)R * KRW + d + 16, v1); }
    }
};
struct EpiKV {
    __device__ __forceinline__ void pair(Frame& F, int R, int n, float v0, float v1) const {
        const float rs = rstd512(F.rowsq, 2, R);
        st_bf(F.kv + (size_t)R * KVW + n, v0 * rs); st_bf(F.kv + (size_t)R * KVW + n + 16, v1 * rs);
    }
};
struct EpiQ {
    __device__ __forceinline__ void pair(Frame& F, int R, int n, float v0, float v1) const {
        const float rs = rstd512(F.rowsq, 1, R);
        v0 *= rs; v1 *= rs; const int d = n % 192; const int b = row_b(R), t = R - b * TROWS;
        if (d >= 128 && t < SEQ) { const int dd = d - 128; const int pos = dd < 32 ? (t >> 6) : (t & 63); rope_pair(F.rope, pos, dd & 15, v0, v1); }
        st_bf(F.q + (size_t)R * QW + n, v0 * MLA_QSCALE); st_bf(F.q + (size_t)R * QW + n + 16, v1 * MLA_QSCALE);
    }
};
struct EpiOut {
    int l;
    __device__ __forceinline__ void one(Frame& F, int R, int n, float v) const {
        const int b = row_b(R), t = R - b * TROWS;
        if (t < SEQ) { const size_t o = ((size_t)b * SEQ + t) * D + n; const float base = (l == 0) ? F.x[o] : F.out[o]; F.out[o] = base + F.mod[(size_t)(l * 3 + b) * 6144 + 2 * D + n] * v; }
        else if (l == 0) { const size_t o = ((size_t)b * CTX + (t - SEQ)) * D + n; F.xc[o] = F.ctx[o] + F.mod[(size_t)(l * 3 + 2) * 6144 + 2 * D + n] * v; }
    }
    __device__ __forceinline__ void pair(Frame& F, int R, int n, float v0, float v1) const { one(F, R, n, v0); one(F, R, n + 16, v1); }
};

__device__ __forceinline__ void rowsq_from_z(Frame& F) {
    PHASE_IDS(F);
    const int gw = F.vcu * NWAVES + F.wave, NGW = F.G * NWAVES;
    for (int R = gw; R < MR; R += NGW) {
#pragma unroll
        for (int j = 0; j < 3; ++j) { const int c0 = j == 0 ? Z_VA : (j == 1 ? Z_CQ : Z_CKV);
            const v4u w = *(const GAS v4u*)(F.z + (size_t)R * ZW + c0 + 8 * F.lane);
            float s = bflo(w.x) * bflo(w.x) + bfhi(w.x) * bfhi(w.x) + bflo(w.y) * bflo(w.y) + bfhi(w.y) * bfhi(w.y) + bflo(w.z) * bflo(w.z) + bfhi(w.z) * bfhi(w.z) + bflo(w.w) * bflo(w.w) + bfhi(w.w) * bfhi(w.w);
            s = wave_sum(s); if (F.lane < 8) F.rowsq[(size_t)(j * 8 + F.lane) * MR + R] = F.lane == 0 ? s : 0.f; }
    }
}

__device__ __forceinline__ void gmlp_naive(Frame& F, int l) {
    PHASE_IDS(F);
    LAS float* Vs = (LAS float*)F.lds;
    LAS float* Ws = (LAS float*)(F.lds + 65536);
    const int nchunk = MR / 128;
    for (int u = F.vcu; u < nchunk * 4; u += F.G) {
        const int ch = u >> 2, g = u & 3; const int R0 = ch * 128; const int t0 = R0 % TROWS;
        if (l == DEPTH - 1 && t0 >= SEQ) continue;
        for (int i = F.tid; i < 128 * 128; i += NTHREADS) { const int q = i >> 7, c = i & 127;
            const float rs = rstd512(F.rowsq, 0, R0 + q);
            Vs[i] = bf2f(F.z[(size_t)(R0 + q) * ZW + Z_VA + g * 128 + c]) * rs;
            Ws[q * 129 + c] = F.w_s[((size_t)(l * 4 + g) * 128 + q) * 128 + c]; }
        __syncthreads();
        for (int i = F.tid; i < 128 * 128; i += NTHREADS) { const int p = i >> 7, c = i & 127; float s = 0.f;
            for (int q = 0; q < 128; ++q) s += Ws[p * 129 + q] * Vs[q * 128 + c];
            const int cc = g * 128 + c; const size_t zr = (size_t)(R0 + p) * ZW;
            const float sv = s * F.sgu_g[l * 512 + cc] + F.b_s[(l * 4 + g) * 128 + p];
            st_bf(F.mix + (size_t)(R0 + p) * D + cc, bf2f(F.z[zr + Z_U + cc]) * sv * bf2f(F.z[zr + Z_GA + cc])); }
        __syncthreads();
    }
}

constexpr int NA_SC = 4352, NA_WAVE_FLOATS = NA_SC + 192;
__device__ __forceinline__ void mla_naive(Frame& F, int l) {
    PHASE_IDS(F);
    LAS float* sc = (LAS float*)F.lds + F.wave * NA_WAVE_FLOATS; LAS float* qs = sc + NA_SC;
    const int gw = F.vcu * NWAVES + F.wave, NGW = F.G * NWAVES;
    for (int it = gw; it < MR * 8; it += NGW) {
        const int R = it >> 3, hh = it & 7; const int b = row_b(R), t = R - b * TROWS; const bool isc = t >= SEQ;
        if (isc && l == DEPTH - 1) continue;
        const int kbase = b * TROWS + (isc ? SEQ : 0), nk = isc ? CTX : TROWS;
        for (int d = F.lane; d < 192; d += 64) qs[d] = bf2f(F.q[(size_t)R * QW + hh * 192 + d]);
        LDS_WAIT();
        float m = -3.0e38f;
        for (int j = F.lane; j < nk; j += 64) { const int Rk = kbase + j; float s = 0.f;
            const bf16* kn = F.kv + (size_t)Rk * KVW + hh * 256; const bf16* kr = F.kr + (size_t)Rk * KRW;
            for (int d = 0; d < 128; d += 8) { const v4u w = *(const GAS v4u*)(kn + d);
                s += qs[d] * bflo(w.x) + qs[d + 1] * bfhi(w.x) + qs[d + 2] * bflo(w.y) + qs[d + 3] * bfhi(w.y) + qs[d + 4] * bflo(w.z) + qs[d + 5] * bfhi(w.z) + qs[d + 6] * bflo(w.w) + qs[d + 7] * bfhi(w.w); }
            for (int d = 0; d < 64; d += 8) { const v4u w = *(const GAS v4u*)(kr + d);
                s += qs[128 + d] * bflo(w.x) + qs[129 + d] * bfhi(w.x) + qs[130 + d] * bflo(w.y) + qs[131 + d] * bfhi(w.y) + qs[132 + d] * bflo(w.z) + qs[133 + d] * bfhi(w.z) + qs[134 + d] * bflo(w.w) + qs[135 + d] * bfhi(w.w); }
            sc[j] = s; m = fmaxf(m, s); }
        m = wave_max(m); float sum = 0.f;
        for (int j = F.lane; j < nk; j += 64) { const float p = __builtin_amdgcn_exp2f(sc[j] - m); sc[j] = p; sum += p; }
        sum = wave_sum(sum); LDS_WAIT();
        float o0 = 0.f, o1 = 0.f;
        for (int j = 0; j < nk; ++j) { const float p = sc[j]; const unsigned w = *(const GAS unsigned*)(F.kv + (size_t)(kbase + j) * KVW + hh * 256 + 128 + 2 * F.lane); o0 += p * bflo(w); o1 += p * bfhi(w); }
        const float inv = 1.0f / sum; const unsigned gw2 = *(const GAS unsigned*)(F.z + (size_t)R * ZW + Z_GB + hh * 128 + 2 * F.lane);
        *(GAS unsigned*)(F.mix + (size_t)R * D + 512 + hh * 128 + 2 * F.lane) = pk2(o0 * inv * bflo(gw2), o1 * inv * bfhi(gw2));
        LDS_WAIT();
    }
}
__device__ __forceinline__ void natten_naive(Frame& F, int l) {
    PHASE_IDS(F);
    LAS float* sc = (LAS float*)F.lds + F.wave * NA_WAVE_FLOATS; LAS float* qs = sc + NA_SC;
    const int gw = F.vcu * NWAVES + F.wave, NGW = F.G * NWAVES;
    for (int it = gw; it < MR * 4; it += NGW) {
        const int R = it >> 2, hh = it & 3; const int b = row_b(R), t = R - b * TROWS; const bool isc = t >= SEQ;
        if (isc && l == DEPTH - 1) continue;
        const int gr = t >> 6, gc = t & 63; const int r0 = min(max(gr - 4, 0), 56), c0 = min(max(gc - 8, 0), 48);
        const int nk = isc ? CTX : 128 + CTX;
        for (int d = F.lane; d < 128; d += 64) qs[d] = bf2f(F.z[(size_t)R * ZW + Z_QC + hh * 128 + d]);
        LDS_WAIT();
        float m = -3.0e38f;
        for (int j = F.lane; j < nk; j += 64) { int Rk; float bias = 0.f;
            if (!isc && j < 128) { const int kr_ = r0 + (j >> 4), kc = c0 + (j & 15); Rk = b * TROWS + kr_ * 64 + kc;
                bias = F.rpb[((size_t)(l * 4 + hh) * 15 + (kr_ - gr + 7)) * 31 + (kc - gc + 15)] * LOG2E; }
            else Rk = b * TROWS + SEQ + (isc ? j : j - 128);
            float s = 0.f; const bf16* kp = F.z + (size_t)Rk * ZW + Z_KC + hh * 128;
            for (int d = 0; d < 128; d += 8) { const v4u w = *(const GAS v4u*)(kp + d);
                s += qs[d] * bflo(w.x) + qs[d + 1] * bfhi(w.x) + qs[d + 2] * bflo(w.y) + qs[d + 3] * bfhi(w.y) + qs[d + 4] * bflo(w.z) + qs[d + 5] * bfhi(w.z) + qs[d + 6] * bflo(w.w) + qs[d + 7] * bfhi(w.w); }
            s += bias; sc[j] = s; m = fmaxf(m, s); }
        m = wave_max(m); float sum = 0.f;
        for (int j = F.lane; j < nk; j += 64) { const float p = __builtin_amdgcn_exp2f(sc[j] - m); sc[j] = p; sum += p; }
        sum = wave_sum(sum); LDS_WAIT();
        float o0 = 0.f, o1 = 0.f;
        for (int j = 0; j < nk; ++j) { int Rk;
            if (!isc && j < 128) Rk = b * TROWS + (r0 + (j >> 4)) * 64 + c0 + (j & 15); else Rk = b * TROWS + SEQ + (isc ? j : j - 128);
            const float p = sc[j]; const unsigned w = *(const GAS unsigned*)(F.z + (size_t)Rk * ZW + Z_VC + hh * 128 + 2 * F.lane); o0 += p * bflo(w); o1 += p * bfhi(w); }
        const float inv = 1.0f / sum; const unsigned gw2 = *(const GAS unsigned*)(F.z + (size_t)R * ZW + Z_GC + hh * 128 + 2 * F.lane);
        *(GAS unsigned*)(F.mix + (size_t)R * D + 1536 + hh * 128 + 2 * F.lane) = pk2(o0 * inv * bflo(gw2), o1 * inv * bfhi(gw2));
        LDS_WAIT();
    }
}


namespace pg8 {
#define PG8_LAS __attribute__((address_space(3)))
typedef unsigned short bf16_t;
typedef short bf16x8 __attribute__((ext_vector_type(8)));
typedef unsigned u32x4 __attribute__((ext_vector_type(4)));
constexpr int BM = 256, BK = 64, HALF = 128, HTB = HALF * BK * 2, STAGE_BYTES = 8 * HTB, NXCD = 8;
__host__ __device__ __forceinline__ int lds_byte(int r, int c) { const int st = (r >> 4) * 2 + (c >> 5), rr = r & 15, cc = c & 31, ob = rr * 64 + cc * 2; return st * 1024 + (ob ^ (((ob >> 9) & 1) << 5)); }
__host__ __device__ __forceinline__ void stage_rc(int b, int& R, int& C) { const int st = b / 1024, sb = b % 1024, swz = sb ^ (((sb >> 9) & 1) << 5); R = (st >> 1) * 16 + swz / 64; C = (st & 1) * 32 + (swz % 64) / 2; }
__host__ __device__ __forceinline__ int perm32(int rho) { const int n = rho >> 4, i = rho & 15; return 8 * (i >> 2) + 4 * n + (i & 3); }
struct Unit { int pm, pn, kind; };
struct Gemm { const bf16_t* A; const bf16_t* Bt; int lda, K; const bf16_t* A1; const bf16_t* Bt1; };
template <int NN, int NN1>
struct TileOrder {
    int a0, n0, a1, n1, c1, L0, L1, G1;
    __device__ __forceinline__ void init(int a0_, int n0_, int a1_, int n1_, int c1_, int L0_, int L1_, int G1_) { a0 = a0_; n0 = n0_; a1 = a1_; n1 = n1_; c1 = c1_; L0 = L0_; L1 = L1_; G1 = G1_; }
    __device__ __forceinline__ bool next(int i, Unit& u) const {
        const int nC = n0 + n1, tot0 = 32 * NN + 2 * nC, total = tot0 + 32 * NN1 + 2 * c1;
        const int L = i == 0 ? L0 : L1 + (i - 1) * G1; if (L < 0 || L >= total) return false;
        const int q = total >> 3, r = total & 7, xcd = L & 7, off = L >> 3; int w = (xcd < r ? xcd * (q + 1) : r * (q + 1) + (xcd - r) * q) + off;
        if (w < tot0) { u.kind = 0;
            if (w < 32 * NN) { const int gid = w / (8 * NN), rem = w % (8 * NN), pmL = gid * 8 + (rem & 7); u.pn = rem >> 3; u.pm = pmL + (pmL >= 16 ? 1 : 0); }
            else { const int wc = w - 32 * NN, pmc = wc >= nC ? 1 : 0, k = wc - pmc * nC; u.pn = k < n0 ? a0 + k : a1 + (k - n0); u.pm = pmc ? 33 : 16; } }
        else { u.kind = 1; w -= tot0;
            if (w < 32 * NN1) { const int gid = w / (8 * (NN1 ? NN1 : 1)), rem = w % (8 * (NN1 ? NN1 : 1)), pmL = gid * 8 + (rem & 7); u.pn = rem >> 3; u.pm = pmL + (pmL >= 16 ? 1 : 0); }
            else { const int wc = w - 32 * NN1, pmc = wc >= c1 ? 1 : 0; u.pn = wc - pmc * c1; u.pm = pmc ? 33 : 16; } }
        return true;
    }
    __device__ __forceinline__ void a_ready(const Unit&) const {}
    __device__ __forceinline__ void done(const Unit&) const {}
};
__device__ __forceinline__ unsigned cvt_pk_bf16(float lo, float hi) { unsigned r; asm volatile("v_cvt_pk_bf16_f32 %0, %1, %2" : "=v"(r) : "v"(lo), "v"(hi)); return r; }

template <class Epi, class Sched, bool ALIGN_EPI = false, bool SP2 = false>
__device__ __forceinline__ void gemm_phase(PG8_LAS unsigned char* lds, const Gemm g, const Sched& S, const Epi& E, const int tid) {
    const int wid = __builtin_amdgcn_readfirstlane(tid >> 6), lane = tid & 63, wr = wid >> 2, wc = wid & 3, fr = lane & 15, fq = lane >> 4;
    const int K = g.K, nt = K / BK, lda = g.lda;
    unsigned voffA[2], voffB[2];
#pragma unroll
    for (int i = 0; i < 2; ++i) { int R, C; stage_rc(tid * 16 + i * 8192, R, C); const int Rb = Epi::PERM ? ((R & ~31) + perm32(R & 31)) : R;
        voffA[i] = (unsigned)(R * lda + C) * 2u; voffB[i] = (unsigned)(Rb * K + C) * 2u; }
    const size_t kstep = (size_t)(BK * 2);
    const size_t hstepA = (size_t)HALF * lda * 2, hstepB = (size_t)HALF * K * 2;
    const size_t tstepA = 2 * hstepA, tstepB = 2 * hstepB;
    const unsigned ldsw = (unsigned)wid * 1024u;
    const int aoff = lds_byte(wr * 64 + fr, fq * 8), boff = lds_byte(wc * 32 + fr, fq * 8);
#define PG8_SA(b, h) (((b) * 2 + (h)) * HTB)
#define PG8_SB(b, h) ((4 + (b) * 2 + (h)) * HTB)
#define PG8_STAGE(bufoff, gbase, voff) do { _Pragma("unroll") for (int _i = 0; _i < 2; ++_i) \
        __builtin_amdgcn_global_load_lds((const unsigned*)((const char*)(gbase) + (voff)[_i]), (PG8_LAS unsigned*)(lds + (bufoff) + ldsw + _i * 8192), 16, 0, 0); } while (0)
#define PG8_LDA(dst, b, h) do { _Pragma("unroll") for (int m = 0; m < 4; ++m) _Pragma("unroll") for (int k = 0; k < 2; ++k) dst[m][k] = *(const PG8_LAS bf16x8*)(lds + PG8_SA(b, h) + aoff + m * 2048 + k * 1024); } while (0)
#define PG8_LDB(dst, b, h) do { _Pragma("unroll") for (int n = 0; n < 2; ++n) _Pragma("unroll") for (int k = 0; k < 2; ++k) dst[n][k] = *(const PG8_LAS bf16x8*)(lds + PG8_SB(b, h) + boff + n * 2048 + k * 1024); } while (0)
#define PG8_MMA(ai, bj, At, Bt) do { __builtin_amdgcn_s_setprio(1); _Pragma("unroll") for (int m = 0; m < 4; ++m) _Pragma("unroll") for (int n = 0; n < 2; ++n) _Pragma("unroll") for (int k = 0; k < 2; ++k) \
        acc[ai][bj][m][n] = __builtin_amdgcn_mfma_f32_16x16x32_bf16(Bt[n][k], At[m][k], acc[ai][bj][m][n], 0, 0, 0); __builtin_amdgcn_s_setprio(0); } while (0)
#define PG8_WAIT_V(n) asm volatile("s_waitcnt vmcnt(" #n ")" ::: "memory")
#define PG8_WAIT_L(n) asm volatile("s_waitcnt lgkmcnt(" #n ")" ::: "memory")
#define PG8_BAR __builtin_amdgcn_s_barrier()
#define PG8_SCHED __builtin_amdgcn_sched_barrier(0)
    Unit cur, nxt; int ui = 0;
    if (!S.next(0, cur)) return;
    f32x4 acc[2][2][4][2];
#pragma unroll
    for (int a = 0; a < 2; ++a)
#pragma unroll
        for (int b = 0; b < 2; ++b)
#pragma unroll
            for (int m = 0; m < 4; ++m)
#pragma unroll
                for (int n = 0; n < 2; ++n) acc[a][b][m][n] = (f32x4){0.f, 0.f, 0.f, 0.f};
    bf16x8 At[4][2], B0[2][2], B1[2][2];
    const char* cA = (const char*)(cur.kind ? g.A1 : g.A) + (size_t)cur.pm * tstepA; const char* cB = (const char*)(cur.kind ? g.Bt1 : g.Bt) + (size_t)cur.pn * tstepB;
    S.a_ready(cur);
    if constexpr (SP2) {
        PG8_STAGE(PG8_SB(0, 0), cB, voffB); PG8_STAGE(PG8_SB(0, 1), cB + hstepB, voffB); PG8_STAGE(PG8_SA(0, 0), cA, voffA); PG8_STAGE(PG8_SA(0, 1), cA + hstepA, voffA);
        if (wr == 1) PG8_BAR;
        PG8_WAIT_V(2); PG8_BAR;
        PG8_STAGE(PG8_SB(1, 0), cB + kstep, voffB); PG8_STAGE(PG8_SA(1, 0), cA + kstep, voffA); PG8_STAGE(PG8_SB(1, 1), cB + hstepB + kstep, voffB);
        PG8_WAIT_V(6); PG8_BAR;
    } else {
        PG8_STAGE(PG8_SB(0, 0), cB, voffB); PG8_STAGE(PG8_SA(0, 0), cA, voffA); PG8_STAGE(PG8_SB(0, 1), cB + hstepB, voffB); PG8_STAGE(PG8_SA(0, 1), cA + hstepA, voffA);
        if (wr == 1) PG8_BAR;
        PG8_WAIT_V(4); PG8_BAR;
        PG8_STAGE(PG8_SB(1, 0), cB + kstep, voffB); PG8_STAGE(PG8_SA(1, 0), cA + kstep, voffA); PG8_STAGE(PG8_SB(1, 1), cB + hstepB + kstep, voffB);
        PG8_WAIT_V(6); PG8_BAR;
    }
    for (;;) {
        const bool has_next = S.next(ui + 1, nxt);
        const char* nA = has_next ? (const char*)(nxt.kind ? g.A1 : g.A) + (size_t)nxt.pm * tstepA : cA; const char* nB = has_next ? (const char*)(nxt.kind ? g.Bt1 : g.Bt) + (size_t)nxt.pn * tstepB : cB;
        for (int t = 0; t < nt; t += 2) {
            const bool last = (t == nt - 2);
            const char* a1 = cA + (size_t)(t + 1) * kstep;
            const char* a2 = last ? nA : cA + (size_t)(t + 2) * kstep; const char* b2 = last ? nB : cB + (size_t)(t + 2) * kstep;
            const char* a3 = a2 + kstep; const char* b3 = b2 + kstep;
            if (last && has_next) S.a_ready(nxt);
            if constexpr (SP2) {
            PG8_LDB(B0, 0, 0); PG8_LDB(B1, 0, 1); PG8_SCHED; PG8_LDA(At, 0, 0); PG8_STAGE(PG8_SA(1, 1), a1 + hstepA, voffA);
            PG8_WAIT_V(8); PG8_WAIT_L(0); PG8_BAR; PG8_MMA(0, 0, At, B0); PG8_MMA(0, 1, At, B1); PG8_BAR; PG8_SCHED;
            PG8_LDA(At, 0, 1); PG8_STAGE(PG8_SB(0, 0), b2, voffB); PG8_STAGE(PG8_SB(0, 1), b2 + hstepB, voffB); PG8_STAGE(PG8_SA(0, 0), a2, voffA);
            PG8_WAIT_V(8); PG8_WAIT_L(0); PG8_BAR; PG8_MMA(1, 0, At, B0); PG8_MMA(1, 1, At, B1); PG8_BAR; PG8_SCHED;
            PG8_LDB(B0, 1, 0); PG8_LDB(B1, 1, 1); PG8_SCHED; PG8_LDA(At, 1, 0); PG8_STAGE(PG8_SA(0, 1), a2 + hstepA, voffA);
            PG8_WAIT_V(8); PG8_WAIT_L(0); PG8_BAR; PG8_MMA(0, 0, At, B0); PG8_MMA(0, 1, At, B1); PG8_BAR; PG8_SCHED;
            PG8_LDA(At, 1, 1); PG8_STAGE(PG8_SB(1, 0), b3, voffB); PG8_STAGE(PG8_SB(1, 1), b3 + hstepB, voffB); PG8_STAGE(PG8_SA(1, 0), a3, voffA);
            PG8_WAIT_V(8); PG8_WAIT_L(0); PG8_BAR; PG8_MMA(1, 0, At, B0); PG8_MMA(1, 1, At, B1); PG8_BAR; PG8_SCHED;
            } else {
            PG8_LDB(B0, 0, 0); PG8_SCHED; PG8_LDA(At, 0, 0); PG8_STAGE(PG8_SA(1, 1), a1 + hstepA, voffA);
            PG8_WAIT_L(8); PG8_BAR; PG8_WAIT_L(0); PG8_MMA(0, 0, At, B0); PG8_BAR; PG8_SCHED;
            PG8_LDB(B1, 0, 1); PG8_STAGE(PG8_SB(0, 0), b2, voffB);
            PG8_BAR; PG8_WAIT_L(0); PG8_MMA(0, 1, At, B1); PG8_BAR;
            PG8_LDA(At, 0, 1); PG8_STAGE(PG8_SA(0, 0), a2, voffA);
            PG8_BAR; PG8_WAIT_L(0); PG8_MMA(1, 0, At, B0); PG8_BAR; PG8_SCHED;
            PG8_STAGE(PG8_SB(0, 1), b2 + hstepB, voffB);
            PG8_WAIT_V(6); PG8_BAR; PG8_MMA(1, 1, At, B1); PG8_BAR;
            PG8_LDB(B0, 1, 0); PG8_SCHED; PG8_LDA(At, 1, 0); PG8_STAGE(PG8_SA(0, 1), a2 + hstepA, voffA);
            PG8_WAIT_L(8); PG8_BAR; PG8_WAIT_L(0); PG8_MMA(0, 0, At, B0); PG8_BAR; PG8_SCHED;
            PG8_LDB(B1, 1, 1); PG8_STAGE(PG8_SB(1, 0), b3, voffB);
            PG8_BAR; PG8_WAIT_L(0); PG8_MMA(0, 1, At, B1); PG8_BAR;
            PG8_LDA(At, 1, 1); PG8_STAGE(PG8_SA(1, 0), a3, voffA);
            PG8_BAR; PG8_WAIT_L(0); PG8_MMA(1, 0, At, B0); PG8_BAR; PG8_SCHED;
            PG8_STAGE(PG8_SB(1, 1), b3 + hstepB, voffB);
            PG8_WAIT_V(6); PG8_BAR; PG8_MMA(1, 1, At, B1); PG8_BAR;
            }
        }
        if constexpr (ALIGN_EPI) { if (wr == 0) PG8_BAR; }
        E(acc, cur, wr, wc, fr, fq); S.done(cur);
        if (!has_next) break;
#pragma unroll
        for (int a = 0; a < 2; ++a)
#pragma unroll
            for (int b = 0; b < 2; ++b)
#pragma unroll
                for (int m = 0; m < 4; ++m)
#pragma unroll
                    for (int n = 0; n < 2; ++n) acc[a][b][m][n] = (f32x4){0.f, 0.f, 0.f, 0.f};
        cur = nxt; cA = nA; cB = nB; ++ui;
        if constexpr (ALIGN_EPI) { if (wr == 1) PG8_BAR; }
    }
    PG8_WAIT_V(0);
    if constexpr (!ALIGN_EPI) { if (wr == 0) PG8_BAR; }
    PG8_BAR;
#undef PG8_SA
#undef PG8_SB
#undef PG8_STAGE
#undef PG8_LDA
#undef PG8_LDB
#undef PG8_MMA
#undef PG8_WAIT_V
#undef PG8_WAIT_L
#undef PG8_BAR
#undef PG8_SCHED
}
}

template <int ACT> __device__ __forceinline__ float actf(float v) { if (ACT == 1) return gelu_f(v); if (ACT == 2) return silu_f(v); if (ACT == 3) return v * C_QSCALE; return v; }
struct FEpiWin {
    static constexpr bool PERM = true, AFTER_DRAIN = false;
    bf16* z; bf16* kr; float* rsq; const float* rope;
    template <int ACT, bool SQ>
    __device__ __forceinline__ void tile(const f32x4 (&acc)[2][2][4][2], int row0, int col0, float* sqp, int fq) const {
#pragma unroll
        for (int ai = 0; ai < 2; ++ai)
#pragma unroll
            for (int m = 0; m < 4; ++m) { const int row = row0 + ai * 128 + m * 16; bf16* rowp = z + (size_t)row * ZW + col0; float s = 0.f;
#pragma unroll
                for (int bj = 0; bj < 2; ++bj) { f32x4 v0 = acc[ai][bj][m][0], v1 = acc[ai][bj][m][1];
#pragma unroll
                    for (int e = 0; e < 4; ++e) { v0[e] = actf<ACT>(v0[e]); v1[e] = actf<ACT>(v1[e]); }
                    if (SQ) s += (v0[0] * v0[0] + v0[1] * v0[1]) + (v0[2] * v0[2] + v0[3] * v0[3]) + (v1[0] * v1[0] + v1[1] * v1[1]) + (v1[2] * v1[2] + v1[3] * v1[3]);
                    v4u w; w.x = pg8::cvt_pk_bf16(v0[0], v0[1]); w.y = pg8::cvt_pk_bf16(v0[2], v0[3]); w.z = pg8::cvt_pk_bf16(v1[0], v1[1]); w.w = pg8::cvt_pk_bf16(v1[2], v1[3]);
                    *(GAS v4u*)(rowp + bj * 128) = w; }
                if (SQ) { s += swz_xor<16>(s); s = sum32(s); if (fq == 0) sqp[row] = s; } }
    }
    __device__ __forceinline__ void operator()(const f32x4 (&acc)[2][2][4][2], const pg8::Unit& u, int wr, int wc, int fr, int fq) const {
        const int row0 = u.pm * 256 + wr * 64 + fr, pn = u.pn;
        if (pn < 22) {
            const int col0 = pn * 256 + wc * 32 + 8 * fq; const int slot = (pn & 1) * 4 + wc;
            if (pn < 2) tile<1, false>(acc, row0, col0, nullptr, fq);
            else if (pn < 4) tile<1, true>(acc, row0, col0, rsq + (size_t)(0 * 8 + slot) * MR, fq);
            else if (pn < 6) tile<2, false>(acc, row0, col0, nullptr, fq);
            else if (pn < 8) tile<0, true>(acc, row0, col0, rsq + (size_t)(1 * 8 + slot) * MR, fq);
            else if (pn < 10) tile<0, true>(acc, row0, col0, rsq + (size_t)(2 * 8 + slot) * MR, fq);
            else if (pn < 14) tile<2, false>(acc, row0, col0, nullptr, fq);
            else if (pn < 16) tile<3, false>(acc, row0, col0, nullptr, fq);
            else if (pn < 20) tile<0, false>(acc, row0, col0, nullptr, fq);
            else tile<2, false>(acc, row0, col0, nullptr, fq);
        } else if (wc < 2) {
#pragma unroll
            for (int ai = 0; ai < 2; ++ai)
#pragma unroll
                for (int m = 0; m < 4; ++m) { const int row = row0 + ai * 128 + m * 16; const int b = row_b(row), t = row - b * TROWS; f32x4 x1 = acc[ai][0][m][0], x2 = acc[ai][0][m][1];
                    if (t < SEQ) { const int pos = wc == 0 ? (t >> 6) : (t & 63); const f32x4 cs = *(const GAS f32x4*)(rope + pos * 16 + 4 * fq), sn = *(const GAS f32x4*)(rope + 1024 + pos * 16 + 4 * fq);
                        const f32x4 a = x1 * cs - x2 * sn, bb = x2 * cs + x1 * sn; x1 = a; x2 = bb; }
                    v4u w; w.x = pg8::cvt_pk_bf16(x1[0], x1[1]); w.y = pg8::cvt_pk_bf16(x1[2], x1[3]); w.z = pg8::cvt_pk_bf16(x2[0], x2[1]); w.w = pg8::cvt_pk_bf16(x2[2], x2[3]);
                    *(GAS v4u*)(kr + (size_t)row * KRW + wc * 32 + 8 * fq) = w; }
        }
    }
};
struct FEpiKV {
    static constexpr bool PERM = true, AFTER_DRAIN = false;
    bf16* kv; const float* rsq;
    __device__ __forceinline__ void operator()(const f32x4 (&acc)[2][2][4][2], const pg8::Unit& u, int wr, int wc, int fr, int fq) const {
        const int row0 = u.pm * 256 + wr * 64 + fr, col0 = u.pn * 256 + wc * 32 + 8 * fq;
#pragma unroll
        for (int ai = 0; ai < 2; ++ai)
#pragma unroll
            for (int m = 0; m < 4; ++m) { const int row = row0 + ai * 128 + m * 16; const float rs = rstd512(rsq, 2, row);
#pragma unroll
                for (int bj = 0; bj < 2; ++bj) { const f32x4 v0 = acc[ai][bj][m][0] * rs, v1 = acc[ai][bj][m][1] * rs;
                    v4u w; w.x = pg8::cvt_pk_bf16(v0[0], v0[1]); w.y = pg8::cvt_pk_bf16(v0[2], v0[3]); w.z = pg8::cvt_pk_bf16(v1[0], v1[1]); w.w = pg8::cvt_pk_bf16(v1[2], v1[3]);
                    *(GAS v4u*)(kv + (size_t)row * KVW + col0 + bj * 128) = w; } }
    }
};
struct FEpiQ {
    static constexpr bool PERM = true, AFTER_DRAIN = false;
    bf16* q; const float* rsq; const float* rope;
    __device__ __forceinline__ void operator()(const f32x4 (&acc)[2][2][4][2], const pg8::Unit& u, int wr, int wc, int fr, int fq) const {
        const int row0 = u.pm * 256 + wr * 64 + fr;
#pragma unroll
        for (int ai = 0; ai < 2; ++ai)
#pragma unroll
            for (int m = 0; m < 4; ++m) { const int row = row0 + ai * 128 + m * 16; const int b = row_b(row), t = row - b * TROWS; const float rs = rstd512(rsq, 1, row);
#pragma unroll
                for (int bj = 0; bj < 2; ++bj) { const int c32 = u.pn * 256 + bj * 128 + wc * 32; const int d0 = c32 % 192;
                    f32x4 x1 = acc[ai][bj][m][0] * rs, x2 = acc[ai][bj][m][1] * rs;
                    if (d0 >= 128 && t < SEQ) { const int pos = d0 == 128 ? (t >> 6) : (t & 63); const f32x4 cs = *(const GAS f32x4*)(rope + pos * 16 + 4 * fq), sn = *(const GAS f32x4*)(rope + 1024 + pos * 16 + 4 * fq);
                        const f32x4 a = x1 * cs - x2 * sn, bb = x2 * cs + x1 * sn; x1 = a; x2 = bb; }
                    x1 = x1 * MLA_QSCALE; x2 = x2 * MLA_QSCALE;
                    v4u w; w.x = pg8::cvt_pk_bf16(x1[0], x1[1]); w.y = pg8::cvt_pk_bf16(x1[2], x1[3]); w.z = pg8::cvt_pk_bf16(x2[0], x2[1]); w.w = pg8::cvt_pk_bf16(x2[2], x2[3]);
                    *(GAS v4u*)(q + (size_t)row * QW + c32 + 8 * fq) = w; } }
    }
};
struct FEpiKVQ {
    static constexpr bool PERM = true, AFTER_DRAIN = false;
    FEpiKV kvE; FEpiQ qE;
    __device__ __forceinline__ void operator()(const f32x4 (&acc)[2][2][4][2], const pg8::Unit& u, int wr, int wc, int fr, int fq) const { if (u.kind == 0) kvE(acc, u, wr, wc, fr, fq); else qE(acc, u, wr, wc, fr, fq); }
};
struct FEpiOut {
    static constexpr bool PERM = false, AFTER_DRAIN = false;
    const float* base; float* out; const float* basec; float* outc; const float* mod; int l;
    __device__ __forceinline__ void operator()(const f32x4 (&acc)[2][2][4][2], const pg8::Unit& u, int wr, int wc, int fr, int fq) const {
        const int row0 = u.pm * 256 + wr * 64 + fr, col0 = u.pn * 256 + wc * 32 + 4 * fq;
        const int b = u.pm >= 17 ? 1 : 0; const bool isc = (u.pm == 16 || u.pm == 33);
        const float* gate = mod + (size_t)(isc ? 2 : b) * 6144 + 2 * D;
        f32x4 gv[2][2];
#pragma unroll
        for (int bj = 0; bj < 2; ++bj)
#pragma unroll
            for (int n = 0; n < 2; ++n) gv[bj][n] = *(const GAS f32x4*)(gate + col0 + bj * 128 + n * 16);
#pragma unroll
        for (int ai = 0; ai < 2; ++ai)
#pragma unroll
            for (int m = 0; m < 4; ++m) { const int row = row0 + ai * 128 + m * 16; const int t = row - b * TROWS;
                const size_t o = isc ? ((size_t)b * CTX + (t - SEQ)) * D : ((size_t)b * SEQ + t) * D; const float* bp = (isc ? basec : base) + o + col0; float* op = (isc ? outc : out) + o + col0;
#pragma unroll
                for (int bj = 0; bj < 2; ++bj)
#pragma unroll
                    for (int n = 0; n < 2; ++n) { const f32x4 bs = *(const GAS f32x4*)(bp + bj * 128 + n * 16); *(GAS f32x4*)(op + bj * 128 + n * 16) = bs + gv[bj][n] * acc[ai][bj][m][n]; } }
    }
};


namespace att {
using bf16x8 = __attribute__((ext_vector_type(8))) short;
using s16x4  = __attribute__((ext_vector_type(4))) short;
using f32x16 = __attribute__((ext_vector_type(16))) float;
using u32x4  = __attribute__((ext_vector_type(4))) unsigned;
constexpr int NW = 8, QBLK = 32, KVBLK = 64;
constexpr int SHM_V = 16384, SHM_KN = 16384, SHM_KR = 8192;
constexpr int OFF_V = 0, OFF_KN = 2 * SHM_V, OFF_KR = OFF_KN + 2 * SHM_KN, OFF_WS = 131072, SHM_ATTN = OFF_WS + NW * 64 * 4;
constexpr float THR = 6.f;
#define AT_KSWZ(row, colB) ((row) * 256 + ((colB) ^ (((row) & 15) << 4)))
#define AT_KRSWZ(row, colB) ((row) * 128 + ((colB) ^ ((((row) >> 1) & 7) << 4)))
#define AT_SBAR() __builtin_amdgcn_sched_barrier(0)
__device__ __forceinline__ int crow(int r, int hi) { return (r & 3) + 8 * (r >> 2) + 4 * hi; }
__device__ __forceinline__ unsigned cvtpk(float lo, float hi) { unsigned r; asm volatile("v_cvt_pk_bf16_f32 %0, %1, %2" : "=v"(r) : "v"(lo), "v"(hi)); return r; }
__device__ __forceinline__ bf16x8 ld8(const bf16* p) { return *reinterpret_cast<const bf16x8*>(p); }

__device__ __forceinline__ void partialSM(f32x16& p0, f32x16& p1, float& m_reg, float& mn, float& alpha) {
  float pmax = p0[0];
#pragma unroll
  for (int r = 1; r < 16; ++r) pmax = fmaxf(pmax, p0[r]);
#pragma unroll
  for (int r = 0; r < 16; ++r) pmax = fmaxf(pmax, p1[r]);
  { auto rr = __builtin_amdgcn_permlane32_swap(__float_as_uint(pmax), __float_as_uint(pmax), false, false);
    pmax = fmaxf(__uint_as_float(rr[0]), __uint_as_float(rr[1])); }
  if (__builtin_expect(__all(pmax - m_reg <= THR), 1)) { mn = m_reg; alpha = 1.f; }
  else { mn = fmaxf(m_reg, pmax); alpha = __builtin_amdgcn_exp2f(m_reg - mn); m_reg = mn; }
#pragma unroll
  for (int r = 0; r < 16; ++r) p0[r] = p0[r] - mn;
#pragma unroll
  for (int r = 0; r < 16; ++r) p1[r] = p1[r] - mn;
#pragma unroll
  for (int r = 0; r < 16; ++r) p0[r] = __builtin_amdgcn_exp2f(p0[r]);
}
__device__ __forceinline__ void finishSM(f32x16& p0, f32x16& p1, float alpha, float& l_reg, bf16x8& pa0, bf16x8& pa1, bf16x8& pa2, bf16x8& pa3) {
#pragma unroll
  for (int r = 0; r < 16; ++r) p1[r] = __builtin_amdgcn_exp2f(p1[r]);
  float ps = 0;
#pragma unroll
  for (int r = 0; r < 16; ++r) ps += p0[r];
#pragma unroll
  for (int r = 0; r < 16; ++r) ps += p1[r];
  { auto rr = __builtin_amdgcn_permlane32_swap(__float_as_uint(ps), __float_as_uint(ps), false, false);
    ps = __uint_as_float(rr[0]) + __uint_as_float(rr[1]); }
  l_reg = l_reg * alpha + ps;
#define AT_PK4(P, BASE, OUT) do { unsigned a0 = cvtpk(P[BASE + 0], P[BASE + 1]), a1 = cvtpk(P[BASE + 2], P[BASE + 3]);   \
    unsigned b0 = cvtpk(P[BASE + 4], P[BASE + 5]), b1 = cvtpk(P[BASE + 6], P[BASE + 7]);                              \
    auto r0 = __builtin_amdgcn_permlane32_swap(a0, b0, false, false); auto r1 = __builtin_amdgcn_permlane32_swap(a1, b1, false, false); \
    u32x4 w = {r0[0], r1[0], r0[1], r1[1]}; OUT = *reinterpret_cast<bf16x8*>(&w); } while (0)
  AT_PK4(p0, 0, pa0); AT_PK4(p0, 8, pa1); AT_PK4(p1, 0, pa2); AT_PK4(p1, 8, pa3);
#undef AT_PK4
}
template <bool HASR>
__device__ __forceinline__ void qkt(f32x16& p0, f32x16& p1, const char* Kn, const char* Kr, const bf16x8* qr, int r32, int hi) {
  p0 = f32x16{}; p1 = f32x16{};
#pragma unroll
  for (int d0 = 0; d0 < 8; ++d0) { const int cb = (d0 * 16 + hi * 8) * 2;
    const bf16x8 b0 = *reinterpret_cast<const bf16x8*>(Kn + AT_KSWZ(r32, cb));
    const bf16x8 b1 = *reinterpret_cast<const bf16x8*>(Kn + AT_KSWZ(32 + r32, cb));
    p0 = __builtin_amdgcn_mfma_f32_32x32x16_bf16(b0, qr[d0], p0, 0, 0, 0);
    p1 = __builtin_amdgcn_mfma_f32_32x32x16_bf16(b1, qr[d0], p1, 0, 0, 0); }
  if constexpr (HASR) {
#pragma unroll
    for (int d0 = 0; d0 < 4; ++d0) { const int cb = (d0 * 16 + hi * 8) * 2;
      const bf16x8 b0 = *reinterpret_cast<const bf16x8*>(Kr + AT_KRSWZ(r32, cb));
      const bf16x8 b1 = *reinterpret_cast<const bf16x8*>(Kr + AT_KRSWZ(32 + r32, cb));
      p0 = __builtin_amdgcn_mfma_f32_32x32x16_bf16(b0, qr[8 + d0], p0, 0, 0, 0);
      p1 = __builtin_amdgcn_mfma_f32_32x32x16_bf16(b1, qr[8 + d0], p1, 0, 0, 0); }
  }
}
__device__ __forceinline__ int v_st(int k, int c) { const int kk = (k & ~0xC) | ((k & 4) << 1) | ((k & 8) >> 1); return ((kk >> 3) * 4 + (c >> 5)) * 512 + ((kk & 7) * 32 + (c & 31)) * 2; }
__device__ __forceinline__ int v_rd_base(int lane) { return ((lane & 3) << 3) | (((lane >> 2) & 3) << 6) | (((lane >> 4) & 1) << 5) | (((lane >> 5) & 1) << 8); }
constexpr int v_rd_off(int d0, int ks, int half) { return d0 * 512 + ks * 4096 + half * 2048; }
template <int OFF> __device__ __forceinline__ s16x4 tr_read(int vb) {
  s16x4 r; asm volatile("ds_read_b64_tr_b16 %0, %1 offset:%2" : "=&v"(r) : "v"(vb), "i"(OFF) : "memory"); return r;
}
template <int D0> __device__ __forceinline__ void pv_one(f32x16& od, int vb, bf16x8 pa0, bf16x8 pa1, bf16x8 pa2, bf16x8 pa3) {
  const s16x4 l0 = tr_read<v_rd_off(D0, 0, 0)>(vb), h0 = tr_read<v_rd_off(D0, 0, 1)>(vb), l1 = tr_read<v_rd_off(D0, 1, 0)>(vb), h1 = tr_read<v_rd_off(D0, 1, 1)>(vb);
  const s16x4 l2 = tr_read<v_rd_off(D0, 2, 0)>(vb), h2 = tr_read<v_rd_off(D0, 2, 1)>(vb), l3 = tr_read<v_rd_off(D0, 3, 0)>(vb), h3 = tr_read<v_rd_off(D0, 3, 1)>(vb);
  asm volatile("s_waitcnt lgkmcnt(0)" ::: "memory"); AT_SBAR();
#define AT_PK(L, H) (bf16x8){L[0], L[1], L[2], L[3], H[0], H[1], H[2], H[3]}
  od = __builtin_amdgcn_mfma_f32_32x32x16_bf16(pa0, AT_PK(l0, h0), od, 0, 0, 0);
  od = __builtin_amdgcn_mfma_f32_32x32x16_bf16(pa1, AT_PK(l1, h1), od, 0, 0, 0);
  od = __builtin_amdgcn_mfma_f32_32x32x16_bf16(pa2, AT_PK(l2, h2), od, 0, 0, 0);
  od = __builtin_amdgcn_mfma_f32_32x32x16_bf16(pa3, AT_PK(l3, h3), od, 0, 0, 0);
#undef AT_PK
}
__device__ __forceinline__ void pv_d0(f32x16* o, int vb, bf16x8 pa0, bf16x8 pa1, bf16x8 pa2, bf16x8 pa3) {
  pv_one<0>(o[0], vb, pa0, pa1, pa2, pa3); pv_one<1>(o[1], vb, pa0, pa1, pa2, pa3); pv_one<2>(o[2], vb, pa0, pa1, pa2, pa3); pv_one<3>(o[3], vb, pa0, pa1, pa2, pa3);
}
struct PlainTiles { __device__ __forceinline__ int row(int t) const { return t * KVBLK; } __device__ __forceinline__ void apply(f32x16&, f32x16&, int) const {} };
template <bool HASR, int ldq, int ldk, int ldr, int ldo, int ldg, class Hook>
__device__ __forceinline__ void attn_unit(const bf16* __restrict__ Qb, const bf16* __restrict__ Knb, const bf16* __restrict__ Vb, const bf16* __restrict__ Krb,
                                          int NT, bf16* __restrict__ Ob, const bf16* __restrict__ Gb, char* lds, int tid, const Hook& H) {
  constexpr int NQ = HASR ? 12 : 8;
  const int wid = tid >> 6, lane = tid & 63, r32 = lane & 31, hi = lane >> 5;
  char* V_lds = lds + OFF_V; char* KN_lds = lds + OFF_KN; char* KR_lds = lds + OFF_KR;
  float* ws = (float*)(lds + OFF_WS) + wid * 64; float* li_l = ws; float* al_l = ws + 32;
  float m_reg = -1e30f, l_reg = 0; f32x16 o[4] = {}; bf16x8 qr[NQ];
  const bf16* Qw = Qb + (size_t)(wid * QBLK + r32) * ldq + hi * 8;
#pragma unroll
  for (int d0 = 0; d0 < NQ; ++d0) qr[d0] = ld8(Qw + d0 * 16);
  const int sr = tid >> 4, sc = (tid & 15) * 8, vst0 = v_st(sr, sc), vst1 = v_st(32 + sr, sc);
  const int krow = tid >> 3, kcc = (tid & 7) * 8;
  const int vb0 = (int)(uintptr_t)V_lds + v_rd_base(lane);
  bf16x8 vs0, vs1, ks0, ks1, rs0;
#define AT_SLOAD(k0) do { vs0 = ld8(&Vb[(size_t)((k0) + sr) * ldk + sc]); vs1 = ld8(&Vb[(size_t)((k0) + 32 + sr) * ldk + sc]); \
    ks0 = ld8(&Knb[(size_t)((k0) + sr) * ldk + sc]); ks1 = ld8(&Knb[(size_t)((k0) + 32 + sr) * ldk + sc]); \
    if constexpr (HASR) rs0 = ld8(&Krb[(size_t)((k0) + krow) * ldr + kcc]); } while (0)
#define AT_SWRITE(b) do { *(bf16x8*)(V_lds + (b) * SHM_V + vst0) = vs0; *(bf16x8*)(V_lds + (b) * SHM_V + vst1) = vs1; const int kc = sc * 2; \
    *(bf16x8*)(KN_lds + (b) * SHM_KN + AT_KSWZ(sr, kc)) = ks0; *(bf16x8*)(KN_lds + (b) * SHM_KN + AT_KSWZ(32 + sr, kc)) = ks1; \
    if constexpr (HASR) *(bf16x8*)(KR_lds + (b) * SHM_KR + AT_KRSWZ(krow, kcc * 2)) = rs0; } while (0)
#define AT_RESC(a) do { if (__any((a) < 1.f)) { if (hi == 0) al_l[r32] = (a); asm volatile("s_waitcnt lgkmcnt(0)" ::: "memory"); \
    _Pragma("unroll") for (int d = 0; d < 4; ++d) _Pragma("unroll") for (int r = 0; r < 16; ++r) o[d][r] *= al_l[crow(r, hi)]; } } while (0)
  f32x16 pA0, pA1, pB0, pB1; float mnA, mnB, alA, alB; bf16x8 pa0, pa1, pa2, pa3;
  AT_SLOAD(H.row(0)); asm volatile("s_waitcnt vmcnt(0)" ::: "memory"); AT_SWRITE(0); __syncthreads();
  qkt<HASR>(pA0, pA1, KN_lds, KR_lds, qr, r32, hi); H.apply(pA0, pA1, 0); partialSM(pA0, pA1, m_reg, mnA, alA);
  AT_SLOAD(H.row(1));
  asm volatile("s_waitcnt vmcnt(0)" ::: "memory"); AT_SWRITE(1); __syncthreads();
  for (int j = 1; j + 1 < NT; j += 2) {
    AT_SBAR(); qkt<HASR>(pB0, pB1, KN_lds + SHM_KN, KR_lds + SHM_KR, qr, r32, hi); H.apply(pB0, pB1, j);
    finishSM(pA0, pA1, alA, l_reg, pa0, pa1, pa2, pa3); AT_SBAR();
    AT_SLOAD(H.row(j + 1)); AT_SBAR();
    pv_d0(o, vb0, pa0, pa1, pa2, pa3); partialSM(pB0, pB1, m_reg, mnB, alB);
    __syncthreads(); asm volatile("s_waitcnt vmcnt(0)" ::: "memory"); AT_SWRITE(0);
    AT_RESC(alB); __syncthreads();
    AT_SBAR(); qkt<HASR>(pA0, pA1, KN_lds, KR_lds, qr, r32, hi); H.apply(pA0, pA1, j + 1);
    finishSM(pB0, pB1, alB, l_reg, pa0, pa1, pa2, pa3); AT_SBAR();
    AT_SLOAD(H.row(j + 2)); AT_SBAR();
    pv_d0(o, vb0 + SHM_V, pa0, pa1, pa2, pa3); partialSM(pA0, pA1, m_reg, mnA, alA);
    __syncthreads(); asm volatile("s_waitcnt vmcnt(0)" ::: "memory"); AT_SWRITE(1);
    AT_RESC(alA); __syncthreads();
  }
  AT_SBAR(); qkt<HASR>(pB0, pB1, KN_lds + SHM_KN, KR_lds + SHM_KR, qr, r32, hi); H.apply(pB0, pB1, NT - 1);
  finishSM(pA0, pA1, alA, l_reg, pa0, pa1, pa2, pa3); AT_SBAR();
  pv_d0(o, vb0, pa0, pa1, pa2, pa3); partialSM(pB0, pB1, m_reg, mnB, alB);
  __syncthreads(); AT_RESC(alB);
  finishSM(pB0, pB1, alB, l_reg, pa0, pa1, pa2, pa3); AT_SBAR();
  pv_d0(o, vb0 + SHM_V, pa0, pa1, pa2, pa3);
  __syncthreads();
  if (hi == 0) li_l[r32] = l_reg;
  { float* stg = (float*)(lds + wid * 16384);
#pragma unroll
    for (int r = 0; r < 16; ++r) { const int orow = crow(r, hi);
#pragma unroll
      for (int d0 = 0; d0 < 4; ++d0) stg[orow * 128 + d0 * 32 + r32] = o[d0][r]; }
    asm volatile("s_waitcnt lgkmcnt(0)" ::: "memory");
    const int cc = (lane & 31) * 4;
#pragma unroll 4
    for (int it = 0; it < 16; ++it) { const int row = it * 2 + hi; const f32x4 v = *(const f32x4*)(stg + row * 128 + cc); const float rl = __builtin_amdgcn_rcpf(li_l[row]);
      const size_t grow = (size_t)(wid * QBLK + row);
      const v2u g = *(const GAS v2u*)(Gb + grow * ldg + cc);
      v2u w; w.x = cvtpk(v[0] * rl * bflo(g.x), v[1] * rl * bfhi(g.x)); w.y = cvtpk(v[2] * rl * bflo(g.y), v[3] * rl * bfhi(g.y));
      *(GAS v2u*)(Ob + grow * ldo + cc) = w; } }
  __syncthreads();
#undef AT_SLOAD
#undef AT_SWRITE
#undef AT_RESC
}
}


namespace att {
constexpr int OFF_TAB = OFF_WS + 2048;
struct NattenTiles {
    int rlo, nb, gr, r0w, qc, c0, hi; const LAS float* tab;
    __device__ __forceinline__ int row(int t) const { return t < 4 ? SEQ + 64 * t : 64 * (rlo + min(t - 4, nb - 1)); }
    __device__ __forceinline__ void apply(f32x16& p0, f32x16& p1, int t) const {
        if (t < 4) return;
        const int kr_ = rlo + (t - 4); const float NEGB = -1e30f;
        if (t - 4 >= nb || (unsigned)(kr_ - r0w) >= 8u) {
#pragma unroll
            for (int r = 0; r < 16; ++r) { p0[r] = NEGB; p1[r] = NEGB; }
            return; }
        const LAS float* tb = tab + (kr_ - gr + 7) * 32 + (15 - qc + 4 * hi);
        const int cb = 4 * hi - c0;
#pragma unroll
        for (int r = 0; r < 16; ++r) { const int kc = (r & 3) + 8 * (r >> 2);
            const float b0 = tb[kc], b1 = tb[kc + 32];
            p0[r] = (unsigned)(kc + cb) < 16u ? p0[r] + b0 : NEGB;
            p1[r] = (unsigned)(kc + 32 + cb) < 16u ? p1[r] + b1 : NEGB;
            if ((r & 3) == 3) __builtin_amdgcn_sched_barrier(0); }
    }
};
}
__device__ __forceinline__ void natten_fast_unit(Frame& F, int l, int n) {
    const int tid = fresh_tid(F.wave0); char* lds = (char*)F.lds;
    const int b = n >> 6, hh = (n >> 4) & 3, j = n & 15;
    LAS float* tab = (LAS float*)(F.lds + att::OFF_TAB);
    if (tid < 480) { const int dr = tid >> 5, dc = tid & 31; tab[tid] = dc < 31 ? F.rpb[((size_t)(l * 4 + hh) * 15 + dr) * 31 + dc] * LOG2E : 0.f; }
    const int wid = tid >> 6, lane = tid & 63;
    att::NattenTiles H; const int g0 = 4 * j, g3 = 4 * j + 3;
    H.rlo = min(max(g0 - 4, 0), 56); const int rhi = min(max(g3 - 4, 0), 56) + 7; H.nb = rhi - H.rlo + 1;
    H.gr = g0 + (wid >> 1); H.r0w = min(max(H.gr - 4, 0), 56); H.qc = (wid & 1) * 32 + (lane & 31); H.c0 = min(max(H.qc - 8, 0), 48); H.hi = lane >> 5; H.tab = tab;
    const int NT = 4 + H.nb + (H.nb & 1);
    const size_t kb = (size_t)b * TROWS, qb = kb + 256 * j;
    att::attn_unit<false, ZW, ZW, 1, D, ZW>(F.z + qb * ZW + Z_QC + hh * 128, F.z + kb * ZW + Z_KC + hh * 128, F.z + kb * ZW + Z_VC + hh * 128, nullptr,
                                            NT, F.mix + qb * D + 1536 + hh * 128, F.z + qb * ZW + Z_GC + hh * 128, lds, tid, H);
}
__device__ __forceinline__ void cctx_fast_unit(Frame& F, int n) {
    const int tid = fresh_tid(F.wave0); char* lds = (char*)F.lds;
    const int b = n >> 2, hh = n & 3; const size_t kb = (size_t)b * TROWS + SEQ;
    att::attn_unit<false, ZW, ZW, 1, D, ZW>(F.z + kb * ZW + Z_QC + hh * 128, F.z + kb * ZW + Z_KC + hh * 128, F.z + kb * ZW + Z_VC + hh * 128, nullptr,
                                            4, F.mix + kb * D + 1536 + hh * 128, F.z + kb * ZW + Z_GC + hh * 128, lds, tid, att::PlainTiles{});
}

__device__ __forceinline__ void gmlp_fast_unit(Frame& F, int l, int ch) {
    using namespace att;
    const int tid = fresh_tid(F.wave0); char* lds = (char*)F.lds;
    const int wid = tid >> 6, lane = tid & 63, r32 = lane & 31, hi = lane >> 5;
    const size_t R0 = (size_t)ch * 128;
    LAS float* rsl = (LAS float*)(F.lds + OFF_WS);
    v4u zz[16];
#pragma unroll
    for (int i = 0; i < 16; ++i) { const int pc = i * 512 + tid; zz[i] = *(const GAS v4u*)(F.z + (R0 + (pc >> 6)) * ZW + Z_VA + (pc & 63) * 8); }
    if (tid < 128) rsl[tid] = rstd512(F.rowsq, 0, (int)R0 + tid);
    const int g = wid >> 1; const bf16* Wg = F.wsb + (size_t)(l * 4 + g) * 128 * 128;
    bf16x8 wf[2][2][4];
#pragma unroll
    for (int pi = 0; pi < 2; ++pi)
#pragma unroll
        for (int t = 0; t < 2; ++t) { const bf16* wp = Wg + (size_t)((2 * (wid & 1) + pi) * 32 + r32) * 128 + t * 64 + hi * 8;
#pragma unroll
            for (int ks = 0; ks < 4; ++ks) wf[pi][t][ks] = ld8(wp + 16 * ks); }
    __syncthreads();
#pragma unroll
    for (int i = 0; i < 16; ++i) { const int pc = i * 512 + tid; const int q = pc >> 6, c = (pc & 63) * 8; const float rs = rsl[q]; const v4u w = zz[i];
        v4u o; o.x = cvtpk(bflo(w.x) * rs, bfhi(w.x) * rs); o.y = cvtpk(bflo(w.y) * rs, bfhi(w.y) * rs); o.z = cvtpk(bflo(w.z) * rs, bfhi(w.z) * rs); o.w = cvtpk(bflo(w.w) * rs, bfhi(w.w) * rs);
        *(LAS v4u*)(F.lds + ((c >> 7) * 2 + (q >> 6)) * 16384 + v_st(q & 63, c & 127)) = o; }
    __syncthreads();
    const int vb = (int)(uintptr_t)lds + g * 32768 + v_rd_base(lane);
    f32x16 o[2][4] = {};
#pragma unroll
    for (int pi = 0; pi < 2; ++pi)
#pragma unroll
        for (int t = 0; t < 2; ++t) pv_d0(o[pi], vb + t * 16384, wf[pi][t][0], wf[pi][t][1], wf[pi][t][2], wf[pi][t][3]);
    __syncthreads();
    LAS float* stg = (LAS float*)(F.lds + wid * 16384);
    const int cc = (lane & 31) * 4; const int gc = g * 128 + cc;
    const f32x4 sg = *(const GAS f32x4*)(F.sgu_g + l * 512 + gc);
#pragma unroll
    for (int pi = 0; pi < 2; ++pi) { const int pb = 2 * (wid & 1) + pi;
        v2u uu[16], ga[16]; float bs[16];
#pragma unroll
        for (int it = 0; it < 16; ++it) { const int p = pb * 32 + it * 2 + hi; const size_t zr = (R0 + p) * ZW;
            uu[it] = *(const GAS v2u*)(F.z + zr + Z_U + gc); ga[it] = *(const GAS v2u*)(F.z + zr + Z_GA + gc); bs[it] = F.b_s[(l * 4 + g) * 128 + p]; }
#pragma unroll
        for (int r = 0; r < 16; ++r) { const int orow = crow(r, hi);
#pragma unroll
            for (int d0 = 0; d0 < 4; ++d0) stg[orow * 128 + d0 * 32 + r32] = o[pi][d0][r]; }
        asm volatile("s_waitcnt lgkmcnt(0)" ::: "memory");
#pragma unroll
        for (int it = 0; it < 16; ++it) { const int row = it * 2 + hi; const int p = pb * 32 + row; const f32x4 v = *(const LAS f32x4*)(stg + row * 128 + cc);
            v2u w; w.x = cvtpk(bflo(uu[it].x) * (v[0] * sg[0] + bs[it]) * bflo(ga[it].x), bfhi(uu[it].x) * (v[1] * sg[1] + bs[it]) * bfhi(ga[it].x));
            w.y = cvtpk(bflo(uu[it].y) * (v[2] * sg[2] + bs[it]) * bflo(ga[it].y), bfhi(uu[it].y) * (v[3] * sg[3] + bs[it]) * bfhi(ga[it].y));
            *(GAS v2u*)(F.mix + (R0 + p) * D + gc) = w; }
        asm volatile("s_waitcnt lgkmcnt(0)" ::: "memory"); }
    __syncthreads();
}
__device__ __forceinline__ void sc_side_natten(Frame& F, int l) { PHASE_IDS(F); const int c = (int)blockIdx.x; if (c < 128) natten_fast_unit(F, l, c); }
__device__ __forceinline__ void sc_side_gmlp(Frame& F, int l) {
    PHASE_IDS(F); const int c = (int)blockIdx.x; const int nch = (l == 0) ? 68 : 64;
    if (c >= 208) for (int i = 255 - c; i < nch; i += 48) { int ch = i; if (l != 0) ch = i + (i >= 32 ? 2 : 0); gmlp_fast_unit(F, l, ch); }
}
__device__ __forceinline__ void sc_side_cctx(Frame& F, int l) { PHASE_IDS(F); const int c = (int)blockIdx.x; if (l == 0 && c >= 208 && c < 216) cctx_fast_unit(F, c - 208); }

__device__ __forceinline__ void mla_fast(Frame& F, int l) {
    PHASE_IDS(F);
    char* lds = (char*)F.lds;
    const int nunits = 256 + (l == 0 ? 16 : 0);
    for (int u = F.vcu; u < nunits; u += F.G) {
        const int tid = fresh_tid(F.wave0);
        int b, hh, q0, k0, nk;
        if (u < 256) { const int bh = u >> 4; b = bh >> 3; hh = bh & 7; q0 = b * TROWS + (u & 15) * 256; k0 = b * TROWS; nk = TROWS; }
        else { const int bh = u - 256; b = bh >> 3; hh = bh & 7; q0 = b * TROWS + SEQ; k0 = q0; nk = CTX; }
        att::attn_unit<true, QW, KVW, KRW, D, ZW>(F.q + (size_t)q0 * QW + hh * 192, F.kv + (size_t)k0 * KVW + hh * 256, F.kv + (size_t)k0 * KVW + hh * 256 + 128, F.kr + (size_t)k0 * KRW,
                             nk / 64, F.mix + (size_t)q0 * D + 512 + hh * 128, F.z + (size_t)q0 * ZW + Z_GB + hh * 128, lds, tid, att::PlainTiles{});
    }
}


__device__ __forceinline__ void ctx_out_block(Frame& F, int c, int tid) {
    const int wid = tid >> 6, lane = tid & 63, r32 = lane & 31, hi = lane >> 5;
    const int j0 = (c >> 4) * 32, n0 = (c & 15) * 128;
#pragma unroll
    for (int rr = 0; rr < 4; ++rr) { const int row = 4 * wid + rr, j = j0 + row; const bf16* mr = F.mix + ((size_t)(j >> 8) * TROWS + SEQ + (j & 255)) * D;
#pragma unroll
        for (int qd = 0; qd < 4; ++qd) *(LAS v4u*)(F.lds + row * ALDS_PITCH + (qd * 512 + lane * 8) * 2) = *(const GAS v4u*)(mr + qd * 512 + lane * 8); }
    __syncthreads();
    sk_f32x16 a0[4], a1[4];
#pragma unroll
    for (int nb = 0; nb < 4; ++nb) a0[nb] = sk_f32x16{};
    skinny_lds<4, false>(F.lds, 32, F.wfout + (size_t)(n0 >> 5) * 128 * 512, a0, a1, tid);
    __syncthreads();
    LAS float* red = (LAS float*)F.lds;
#pragma unroll
    for (int nb = 0; nb < 4; ++nb)
#pragma unroll
        for (int r = 0; r < 16; ++r) red[(wid * 32 + sk_crow(r, hi)) * 128 + nb * 32 + r32] = a0[nb][r];
    __syncthreads();
    const float* gate = F.mod + (size_t)2 * 6144 + 2 * D;
    for (int e = tid; e < 32 * 128; e += NTHREADS) { const int row = e >> 7, col = e & 127; const size_t o = (size_t)(j0 + row) * D + n0 + col;
        F.xc[o] = F.ctx[o] + gate[n0 + col] * red_sum8(red, 32 * 128, row * 128 + col); }
    __syncthreads();
}

constexpr int NPHASES = 14;
typedef __attribute__((address_space(4))) const Args KArgs;
__device__ __forceinline__ void make_frame(Frame& F, LAS unsigned char* lds, int wave0) {
    KArgs* ka = (KArgs*)__builtin_amdgcn_kernarg_segment_ptr(); asm volatile("" : "+s"(ka));
    F.lds = lds; F.wave0 = wave0; PHASE_IDS(F);
    F.G = gridDim.x; { const int bx = blockIdx.x; F.vcu = (F.G % 8 == 0) ? (bx % 8) * (F.G / 8) + bx / 8 : bx; }
    F.x = ka->in[0]; F.c = ka->in[1]; F.ctx = ka->in[2]; F.c_ctx = ka->in[3]; F.w_ada = ka->in[4]; F.b_ada = ka->in[5]; F.norm_g = ka->in[6]; F.w_in = ka->in[7];
    F.qa_g = ka->in[8]; F.kva_g = ka->in[9]; F.w_uq = ka->in[10]; F.w_ukv = ka->in[11]; F.sgu_g = ka->in[12]; F.w_s = ka->in[13]; F.b_s = ka->in[14]; F.rpb = ka->in[15];
    F.w_out = ka->in[16]; F.final_g = ka->in[17]; F.out = ka->out;
    unsigned char* ws = ka->ws; F.ws = ws; F.probe = 0;
    F.mod = (float*)(ws + WS_MOD); F.rope = (float*)(ws + WS_ROPE); F.rowsq = (float*)(ws + WS_ROWSQ); F.xc = (float*)(ws + WS_XC);
    F.kr = (bf16*)(ws + WS_KR); F.wuq = (bf16*)(ws + WS_WUQ); F.wukv = (bf16*)(ws + WS_WUKV); F.wout = (bf16*)(ws + WS_WOUT); F.win = (bf16*)(ws + WS_WIN);
    F.h = (bf16*)(ws + WS_H); F.z = (bf16*)(ws + WS_Z); F.q = (bf16*)(ws + WS_Q); F.kv = (bf16*)(ws + WS_KV); F.mix = (bf16*)(ws + WS_MIX); F.wsb = (bf16*)(ws + WS_WSB); F.wfkr = (bf16*)(ws + WS_WFKR); F.wfout = (bf16*)(ws + WS_WFOUT);
}
__global__ void __launch_bounds__(NTHREADS, 2) mk_fwd(Args args) {
    extern __shared__ __attribute__((aligned(16))) unsigned char lds[];
    LAS unsigned char* const ldsp = (LAS unsigned char*)lds;
    const int wave0 = __builtin_amdgcn_readfirstlane((int)threadIdx.x >> 6);
    volatile LAS unsigned* MISC = (volatile LAS unsigned*)(ldsp + MISC_OFF);
    { const int t0 = fresh_tid(wave0); for (int u = t0; u < (LDS_BYTES - LDSCTL_OFF) / 4; u += NTHREADS) ((LAS unsigned*)(ldsp + LDSCTL_OFF))[u] = 0u;
      __syncthreads();
      if (MK_ONE_LAUNCH) (void)xcd_barrier_post((unsigned*)(args.ws + WS_CTL) + CW_BAR, MISC + 8, t0); }
    const int lo = args.ph_lo, hi = args.ph_hi;
#if MK_ONE_LAUNCH
#define IN(k) true
#else
#define IN(k) (lo <= (k) && (k) < hi)
#endif
#if PROBE_REP >= 0 && PROBE_REP < 100
#define REP(k) for (int rep_ = 0; rep_ < (PROBE_REP == (k) ? 2 : 1); ++rep_)
#else
#define REP(k)
#endif
#define SEAM(k) do { if (IN(k) && IN((k) + 1)) { KArgs* ka_ = (KArgs*)__builtin_amdgcn_kernarg_segment_ptr(); asm volatile("" : "+s"(ka_)); xcd_barrier((unsigned*)(ka_->ws + WS_CTL) + CW_BAR, MISC + 8, fresh_tid(wave0)); } } while (0)
    if (IN(0)) REP(0) { Frame F; make_frame(F, ldsp, wave0); p0_prologue(F); } SEAM(0);
    for (int l = 0; l < DEPTH; ++l) {
        const int pb = 1 + 6 * l;
        if (IN(pb + 0)) REP(pb + 0) { Frame F; make_frame(F, ldsp, wave0); sa_phase(F, l); } SEAM(pb + 0);
#if FAST_GEMM
        if (IN(pb + 1)) REP(pb + 1) { Frame F; make_frame(F, ldsp, wave0); __syncthreads();
            pg8::Gemm g{F.h, F.win + (size_t)l * NIN_PAD * D, D, D, nullptr, nullptr}; pg8::TileOrder<22, 0> S; if (l == 0) S.init(0, 22, 0, 0, 0, (int)blockIdx.x, (int)blockIdx.x + F.G, F.G); else S.init(8, 2, 16, 4, 0, (int)blockIdx.x, (int)blockIdx.x + F.G, F.G);
            FEpiWin E{F.z, F.kr, F.rowsq, F.rope};
            pg8::gemm_phase<FEpiWin, pg8::TileOrder<22, 0>, true, true>(F.lds, g, S, E, fresh_tid(F.wave0)); } SEAM(pb + 1);
        SEAM(pb + 2);
        if (IN(pb + 3)) REP(pb + 3) { Frame F; make_frame(F, ldsp, wave0); __syncthreads();
            { const int cb = (int)blockIdx.x;
              pg8::Gemm g{F.z + Z_CKV, F.wukv + (size_t)l * KVW * 512, ZW, 512, F.z + Z_CQ, F.wuq + (size_t)l * QW * 512}; pg8::TileOrder<8, 6> S;
              if (F.G == 256) S.init(0, 8, 0, 0, l == 0 ? 6 : 0, cb, cb >= 128 ? cb + 128 : -1000000, 128);
              else S.init(0, 8, 0, 0, l == 0 ? 6 : 0, cb, cb + F.G, F.G);
              FEpiKVQ E{FEpiKV{F.kv, F.rowsq}, FEpiQ{F.q, F.rowsq, F.rope}};
              SUBREP(F, 141 + 10 * l) pg8::gemm_phase<FEpiKVQ, pg8::TileOrder<8, 6>, true, true>(F.lds, g, S, E, fresh_tid(F.wave0)); }
#if FAST_SIDE
            __syncthreads();
            SUBREP(F, 142 + 10 * l) { Frame F2; make_frame(F2, ldsp, wave0); sc_side_natten(F2, l); }
            SUBREP(F, 143 + 10 * l) { Frame F2; make_frame(F2, ldsp, wave0); sc_side_gmlp(F2, l); }
            SUBREP(F, 144 + 10 * l) { Frame F2; make_frame(F2, ldsp, wave0); sc_side_cctx(F2, l); }
#else
            __syncthreads(); gmlp_naive(F, l);
            __syncthreads(); natten_naive(F, l);
#endif
        } SEAM(pb + 3);
#else
        if (IN(pb + 1)) REP(pb + 1) { Frame F; make_frame(F, ldsp, wave0); __syncthreads(); naive_gemm(F, F.h, D, F.win + (size_t)l * NIN_PAD * D, MR, NIN, D, EpiWin{}); } SEAM(pb + 1);
        if (IN(pb + 2)) REP(pb + 2) { Frame F; make_frame(F, ldsp, wave0); rowsq_from_z(F); } SEAM(pb + 2);
        if (IN(pb + 3)) REP(pb + 3) { Frame F; make_frame(F, ldsp, wave0);
            __syncthreads(); naive_gemm(F, F.z + Z_CKV, ZW, F.wukv + (size_t)l * KVW * 512, MR, KVW, 512, EpiKV{});
            __syncthreads(); naive_gemm(F, F.z + Z_CQ, ZW, F.wuq + (size_t)l * QW * 512, MR, QW, 512, EpiQ{});
            __syncthreads(); gmlp_naive(F, l);
            __syncthreads(); natten_naive(F, l);
        } SEAM(pb + 3);
#endif
#if FAST_MLA
        if (IN(pb + 4)) REP(pb + 4) { Frame F; make_frame(F, ldsp, wave0); __syncthreads(); mla_fast(F, l); } SEAM(pb + 4);
#else
        if (IN(pb + 4)) REP(pb + 4) { Frame F; make_frame(F, ldsp, wave0); __syncthreads(); mla_naive(F, l); } SEAM(pb + 4);
#endif
#if FAST_GEMM
        if (IN(pb + 5)) REP(pb + 5) { Frame F; make_frame(F, ldsp, wave0); __syncthreads();
            pg8::Gemm g{F.mix, F.wout + (size_t)l * D * D, D, D, nullptr, nullptr}; pg8::TileOrder<8, 0> S; S.init(0, 0, 0, 0, 0, (int)blockIdx.x, (int)blockIdx.x + F.G, F.G);
            FEpiOut E{l == 0 ? F.x : F.out, F.out, F.ctx, F.xc, F.mod + (size_t)l * 3 * 6144, l};
            pg8::gemm_phase<FEpiOut, pg8::TileOrder<8, 0>, true, true>(F.lds, g, S, E, fresh_tid(F.wave0));
            if (l == 0) for (int cblk = (int)blockIdx.x; cblk < 256; cblk += F.G) ctx_out_block(F, cblk, fresh_tid(F.wave0)); } SEAM(pb + 5);
#else
        if (IN(pb + 5)) REP(pb + 5) { Frame F; make_frame(F, ldsp, wave0); __syncthreads(); naive_gemm(F, F.mix, D, F.wout + (size_t)l * D * D, MR, D, D, EpiOut{l}); } SEAM(pb + 5);
#endif
    }
    if (IN(13)) REP(13) { Frame F; make_frame(F, ldsp, wave0); final_phase(F); }
#undef IN
#undef SEAM
}

extern "C" void kernel_launch(void* const* d_in, const int* in_sizes, int n_in, void* d_out, int out_size, void* d_ws, size_t ws_size, hipStream_t stream) {
    static int grid = 0;
    if (grid == 0) {
        if (n_in != 18 || in_sizes[0] != NBATCH * SEQ * D || out_size != NBATCH * SEQ * D || ws_size < WS_END) {
            fprintf(stderr, "kernel_launch: unexpected shapes: n_in %d in0 %d out %d ws %zu (need %zu)\n", n_in, n_in > 0 ? in_sizes[0] : -1, out_size, ws_size, (size_t)WS_END); grid = -1; return; }
        int dev = 0, cus = 0;
        if (hipGetDevice(&dev) != hipSuccess || hipDeviceGetAttribute(&cus, hipDeviceAttributeMultiprocessorCount, dev) != hipSuccess) { grid = -1; return; }
        if (hipFuncSetAttribute((const void*)mk_fwd, hipFuncAttributeMaxDynamicSharedMemorySize, LDS_BYTES) != hipSuccess) { fprintf(stderr, "kernel_launch: hipFuncSetAttribute failed\n"); grid = -1; return; }
        int per_cu = 0;
        if (hipOccupancyMaxActiveBlocksPerMultiprocessor(&per_cu, (const void*)mk_fwd, NTHREADS, LDS_BYTES) != hipSuccess || per_cu < 1) fprintf(stderr, "kernel_launch: occupancy query says %d\n", per_cu);
        (void)hipGetLastError();
        grid = cus;
        if (cus != 256) { fprintf(stderr, "kernel_launch: built for a 256-CU device (row and unit deals), found %d CUs; nothing launched\n", cus); grid = -1; return; }
    }
    if (grid < 0) return;
    (void)hipMemsetAsync((char*)d_ws + WS_CTL, 0, CTL_ZERO_BYTES, stream);
    Args a{};
    for (int i = 0; i < 18; ++i) a.in[i] = (const float*)d_in[i];
    a.out = (float*)d_out; a.ws = (unsigned char*)d_ws; a.probe = PROBE_REP;
#if MK_ONE_LAUNCH
    a.ph_lo = 0; a.ph_hi = NPHASES;
    hipLaunchKernelGGL(mk_fwd, dim3(grid), dim3(NTHREADS), LDS_BYTES, stream, a);
#else
    for (int p = 0; p < NPHASES; ++p) { a.ph_lo = p; a.ph_hi = p + 1; hipLaunchKernelGGL(mk_fwd, dim3(grid), dim3(NTHREADS), LDS_BYTES, stream, a); }
#endif
    const hipError_t le = hipPeekAtLastError();
    if (le != hipSuccess) fprintf(stderr, "kernel_launch: launch failed: %s\n", hipGetErrorName(le));
}
```
